# Optimizing an MI355X kernel written in HIP

```python
import jax, jax.numpy as jnp
from jax import lax
import numpy as np

D_MODEL = 1024
BATCH = 8
SEQ = 4096
DEPTH = 4

D_MIX = D_MODEL
D_POOL = D_MIX // 2
N_POOL_GROUPS = 4
POOL_GROUP = D_POOL // N_POOL_GROUPS
POOL_WINDOWS = (2, 4, 8, 16)
N_MLA_HEADS = 4
QK_NOPE = 128
QK_ROPE = 64
V_HEAD = 128
D_MLA = N_MLA_HEADS * V_HEAD
Q_LORA = 256
KV_LORA = 128
D_IN = D_POOL + Q_LORA + KV_LORA + QK_ROPE
ROPE_THETA = 10000.0
Q_BLOCK = 128
N_MEM = 256
N_XHEADS = 4
XHEAD = D_MODEL // N_XHEADS
N_EXPERTS = 16
CAPACITY_FACTOR = 2
D_EXPERT = 2 * D_MODEL
EPS = 1e-6

kernel_name = "hybrid_pool_mla_memxattn_ecmoe_encoder"


def rmsnorm(t, gain):
    t32 = t.astype(jnp.float32)
    y = t32 * lax.rsqrt(jnp.mean(t32 * t32, axis=-1, keepdims=True) + EPS) * gain.astype(jnp.float32)
    return y.astype(t.dtype)


def apply_rope(t, cos, sin):
    t1, t2 = jnp.split(t.astype(jnp.float32), 2, axis=-1)
    return jnp.concatenate([t1 * cos - t2 * sin, t1 * sin + t2 * cos], axis=-1).astype(t.dtype)


def pool_mixer(u, w_pool, pool_scale):
    B, S, _ = u.shape
    u32 = u.astype(jnp.float32)
    cs = jnp.concatenate([jnp.zeros((B, 1, D_POOL), jnp.float32), jnp.cumsum(u32, axis=1)], axis=1)
    t = jnp.arange(S)
    outs = []
    for g, w in enumerate(POOL_WINDOWS):
        left = w // 2
        right = w - 1 - left
        lo = jnp.clip(t - left, 0, S)
        hi = jnp.clip(t + right + 1, 0, S)
        sl = slice(g * POOL_GROUP, (g + 1) * POOL_GROUP)
        csg = cs[:, :, sl]
        mean = (csg[:, hi] - csg[:, lo]) / (hi - lo).astype(jnp.float32)[:, None]
        outs.append(jnp.einsum('bsc,cd->bsd', (mean - u32[:, :, sl]).astype(u.dtype), w_pool[g]))
    return jnp.concatenate(outs, axis=-1) * pool_scale


def mla_attention(q_nope, q_rope, k_nope, k_rope, v):
    B, S, H, _ = q_nope.shape
    nb = S // Q_BLOCK
    scale = (QK_NOPE + QK_ROPE) ** -0.5

    def blocks(t):
        return jnp.moveaxis(t.reshape(B, nb, Q_BLOCK, *t.shape[2:]), 1, 0)

    def one_block(args):
        qn, qr = args
        s = jnp.einsum('bqhd,bkhd->bhqk', qn, k_nope) + jnp.einsum('bqhr,bkr->bhqk', qr, k_rope)
        p = jax.nn.softmax(s.astype(jnp.float32) * scale, axis=-1).astype(v.dtype)
        return jnp.einsum('bhqk,bkhd->bqhd', p, v)

    o = lax.map(one_block, (blocks(q_nope), blocks(q_rope)))
    return jnp.moveaxis(o, 0, 1).reshape(B, S, H * V_HEAD)


def memory_cross_attention(h, m, wq, wkv, wo):
    B, S, _ = h.shape
    M = m.shape[1]
    q = (h @ wq).reshape(B, S, N_XHEADS, XHEAD)
    k, v = jnp.split(m @ wkv, 2, axis=-1)
    k = k.reshape(B, M, N_XHEADS, XHEAD)
    v = v.reshape(B, M, N_XHEADS, XHEAD)
    s = jnp.einsum('bqhd,bkhd->bhqk', q, k).astype(jnp.float32) * (XHEAD ** -0.5)
    p = jax.nn.softmax(s, axis=-1).astype(v.dtype)
    o = jnp.einsum('bhqk,bkhd->bqhd', p, v).reshape(B, S, D_MODEL)
    return o @ wo


def expert_choice_ffn(h, w_router, w_gate, w_up, w_down):
    B, S, D = h.shape
    cap = CAPACITY_FACTOR * S // N_EXPERTS
    affinity = jax.nn.softmax(h.astype(jnp.float32) @ w_router.astype(jnp.float32), axis=-1)
    gates, idx = lax.top_k(jnp.swapaxes(affinity, 1, 2), cap)
    b_idx = jnp.arange(B)[:, None, None]
    xt = h[b_idx, idx]
    a = jnp.einsum('becd,edf->becf', xt, w_gate)
    g = jnp.einsum('becd,edf->becf', xt, w_up)
    y = jnp.einsum('becf,efd->becd', jax.nn.silu(a) * g, w_down) * gates[..., None].astype(h.dtype)
    return jnp.zeros_like(h).at[b_idx, idx].add(y)


def setup_inputs(seed: int = 0) -> dict:
    key = jax.random.key(seed)
    ks = jax.random.split(key, 24)
    L = DEPTH

    def w(k, shape, fan_in):
        return jax.random.normal(k, shape, jnp.float32) * (fan_in ** -0.5)

    def gain(k, shape):
        return 1.0 + 0.05 * jax.random.normal(k, shape, jnp.float32)

    x = jax.random.normal(ks[0], (BATCH, SEQ, D_MODEL), jnp.float32)
    mem = jax.random.normal(ks[1], (BATCH, N_MEM, D_MODEL), jnp.float32)
    offsets = jax.random.randint(ks[2], (BATCH, 1), 0, 1024, dtype=jnp.int32)
    positions = offsets + jnp.arange(SEQ, dtype=jnp.int32)[None, :]
    return {
        "x": x,
        "mem": mem,
        "positions": positions,
        "norm_mix": gain(ks[3], (L, D_MODEL)),
        "w_in": w(ks[4], (L, D_MODEL, D_IN), D_MODEL),
        "q_norm": gain(ks[5], (L, Q_LORA)),
        "kv_norm": gain(ks[6], (L, KV_LORA)),
        "w_uq": w(ks[7], (L, Q_LORA, N_MLA_HEADS * (QK_NOPE + QK_ROPE)), Q_LORA),
        "w_ukv": w(ks[8], (L, KV_LORA, N_MLA_HEADS * (QK_NOPE + V_HEAD)), KV_LORA),
        "w_pool": w(ks[9], (L, N_POOL_GROUPS, POOL_GROUP, POOL_GROUP), POOL_GROUP),
        "pool_scale": gain(ks[10], (L, D_POOL)),
        "w_out": w(ks[11], (L, D_MIX, D_MODEL), D_MIX),
        "norm_x": gain(ks[12], (L, D_MODEL)),
        "mem_norm": gain(ks[13], (L, D_MODEL)),
        "wx_q": w(ks[14], (L, D_MODEL, D_MODEL), D_MODEL),
        "wx_kv": w(ks[15], (L, D_MODEL, 2 * D_MODEL), D_MODEL),
        "wx_o": w(ks[16], (L, D_MODEL, D_MODEL), D_MODEL),
        "norm_ffn": gain(ks[17], (L, D_MODEL)),
        "w_router": w(ks[18], (L, D_MODEL, N_EXPERTS), D_MODEL),
        "w_gate": w(ks[19], (L, N_EXPERTS, D_MODEL, D_EXPERT), D_MODEL),
        "w_up": w(ks[20], (L, N_EXPERTS, D_MODEL, D_EXPERT), D_MODEL),
        "w_down": w(ks[21], (L, N_EXPERTS, D_EXPERT, D_MODEL), D_EXPERT),
        "norm_final": gain(ks[22], (D_MODEL,)),
    }


def reference(x, mem, positions, norm_mix, w_in, q_norm, kv_norm, w_uq, w_ukv, w_pool, pool_scale,
              w_out, norm_x, mem_norm, wx_q, wx_kv, wx_o, norm_ffn, w_router, w_gate, w_up, w_down,
              norm_final):
    B, S, _ = x.shape
    half = QK_ROPE // 2
    inv_freq = ROPE_THETA ** (-jnp.arange(half, dtype=jnp.float32) / half)
    ang = positions.astype(jnp.float32)[..., None] * inv_freq
    cos, sin = jnp.cos(ang), jnp.sin(ang)
    splits = [D_POOL, D_POOL + Q_LORA, D_POOL + Q_LORA + KV_LORA]

    for l in range(DEPTH):
        h = rmsnorm(x, norm_mix[l])
        proj = h @ w_in[l]
        u, c_q, c_kv, k_r = jnp.split(proj, splits, axis=-1)
        pool_out = pool_mixer(u, w_pool[l], pool_scale[l])
        q = (rmsnorm(c_q, q_norm[l]) @ w_uq[l]).reshape(B, S, N_MLA_HEADS, QK_NOPE + QK_ROPE)
        q_nope, q_rope = jnp.split(q, [QK_NOPE], axis=-1)
        kv = (rmsnorm(c_kv, kv_norm[l]) @ w_ukv[l]).reshape(B, S, N_MLA_HEADS, QK_NOPE + V_HEAD)
        k_nope, v = jnp.split(kv, [QK_NOPE], axis=-1)
        q_rope = apply_rope(q_rope, cos[:, :, None, :], sin[:, :, None, :])
        k_rope = apply_rope(k_r, cos, sin)
        mla_out = mla_attention(q_nope, q_rope, k_nope, k_rope, v)
        x = x + jnp.concatenate([pool_out, mla_out], axis=-1) @ w_out[l]

        h = rmsnorm(x, norm_x[l])
        m = rmsnorm(mem, mem_norm[l])
        x = x + memory_cross_attention(h, m, wx_q[l], wx_kv[l], wx_o[l])

        h = rmsnorm(x, norm_ffn[l])
        x = x + expert_choice_ffn(h, w_router[l], w_gate[l], w_up[l], w_down[l])

    return rmsnorm(x, norm_final)
```

```cpp
#include <hip/hip_runtime.h>
#include <stdint.h>
#include <stdio.h>
#include <math.h>

constexpr int NB = 8, SEQ = 4096, T = NB * SEQ, DM = 1024, NL = 4;
constexpr int DPOOL = 512, QLORA = 256, KVLORA = 128, QKROPE = 64, DIN = 960;
constexpr int NH = 4, DQK = 192, DV = 128;
constexpr int NMEM = 256, NXH = 4, XHD = 256;
constexpr int NE = 16, CAP = 512, DE = 2048, NROWS = NB * NE * CAP;
constexpr float EPS = 1e-6f;

typedef unsigned short bf16_t;
typedef short bf16x8 __attribute__((ext_vector_type(8)));
typedef float f32x4 __attribute__((ext_vector_type(4)));
typedef float f32x2 __attribute__((ext_vector_type(2)));
typedef float f32x16 __attribute__((ext_vector_type(16)));
typedef short s16x4 __attribute__((ext_vector_type(4)));
typedef unsigned u32x4 __attribute__((ext_vector_type(4)));
typedef unsigned u32x2 __attribute__((ext_vector_type(2)));

constexpr size_t MiB = 1ull << 20;
constexpr size_t OFF_BAR = 0;
constexpr size_t OFF_WIN = 1 * MiB;
constexpr size_t OFF_WUQ = OFF_WIN + 8 * MiB;
constexpr size_t OFF_WUKV = OFF_WUQ + 2 * MiB;
constexpr size_t OFF_WPOOL = OFF_WUKV + 1 * MiB;
constexpr size_t OFF_WOUT = OFF_WPOOL + 2 * MiB;
constexpr size_t OFF_WXQ = OFF_WOUT + 8 * MiB;
constexpr size_t OFF_WXK = OFF_WXQ + 8 * MiB;
constexpr size_t OFF_WXV = OFF_WXK + 8 * MiB;
constexpr size_t OFF_WXO = OFF_WXV + 8 * MiB;
constexpr size_t OFF_WGU = OFF_WXO + 8 * MiB;
constexpr size_t OFF_WD = OFF_WGU + 512 * MiB;
constexpr size_t OFF_XB = OFF_WD + 256 * MiB;
constexpr size_t OFF_RSA = OFF_XB + 64 * MiB;
constexpr size_t OFF_RSC = OFF_RSA + 1 * MiB;
constexpr size_t OFF_SSPB = OFF_RSC + 1 * MiB;
constexpr size_t OFF_CS = OFF_SSPB + 2 * MiB;
constexpr size_t OFF_MB = OFF_CS + 8 * MiB;
constexpr size_t OFF_KX = OFF_MB + 16 * MiB;
constexpr size_t OFF_VXT = OFF_KX + 16 * MiB;
constexpr size_t OFF_MT = OFF_VXT + 16 * MiB;
constexpr size_t OFF_NT = OFF_MT + 64 * MiB;
constexpr size_t OFF_SCR = OFF_NT + 64 * MiB;
constexpr size_t OFF_PROJ = OFF_SCR;
constexpr size_t OFF_DP = OFF_PROJ + 64 * MiB;
constexpr size_t OFF_RSQ = OFF_DP + 32 * MiB;
constexpr size_t OFF_RSKV = OFF_RSQ + 1 * MiB;
constexpr size_t OFF_QF = OFF_RSKV + 1 * MiB;
constexpr size_t OFF_KF = OFF_QF + 48 * MiB;
constexpr size_t OFF_VF = OFF_KF + 48 * MiB;
constexpr size_t OFF_CAT = OFF_VF + 32 * MiB;
constexpr size_t OFF_QX = OFF_CAT + 64 * MiB;
constexpr size_t OFF_SX = OFF_QX + 64 * MiB;
constexpr size_t OFF_P = OFF_SX + 128 * MiB;
constexpr size_t OFF_OX = OFF_P + 64 * MiB;
constexpr size_t END_A = OFF_OX + 64 * MiB;
constexpr size_t OFF_AFF = OFF_SCR;
constexpr size_t OFF_SLOT = OFF_AFF + 2 * MiB;
constexpr size_t OFF_GATE = OFF_SLOT + 2 * MiB;
constexpr size_t OFF_RSROW = OFF_GATE + 1 * MiB;
constexpr size_t OFF_XT = OFF_RSROW + 1 * MiB;
constexpr size_t OFF_ACT = OFF_XT + 128 * MiB;
constexpr size_t OFF_Y = OFF_ACT + 256 * MiB;
constexpr size_t END_B = OFF_Y + 128 * MiB;
constexpr size_t WS_NEED = END_A > END_B ? END_A : END_B;

constexpr int LDS_BYTES = 160 * 1024;
constexpr int NTHREADS = 512;

struct Params {
    const float* x; const float* mem; const int* pos; const float* norm_mix; const float* w_in; const float* q_norm; const float* kv_norm;
    const float* w_uq; const float* w_ukv; const float* w_pool; const float* pool_scale; const float* w_out; const float* norm_x; const float* mem_norm;
    const float* wx_q; const float* wx_kv; const float* wx_o; const float* norm_ffn; const float* w_router; const float* w_gate; const float* w_up;
    const float* w_down; const float* norm_final;
    float* out; unsigned char* ws;
    float inv_freq[32];
    int ph_lo, ph_hi;
};

typedef const __attribute__((address_space(4))) Params* KP;
__device__ __forceinline__ KP kargs() { const unsigned long long a = (unsigned long long)__builtin_amdgcn_kernarg_segment_ptr(); int lo = (int)(unsigned)a, hi = (int)(unsigned)(a >> 32);
    asm volatile("" : "+s"(lo), "+s"(hi)); return (KP)(((unsigned long long)(unsigned)hi << 32) | (unsigned long long)(unsigned)lo); }
__device__ __forceinline__ int lnd_v(int v) { asm volatile("" : "+v"(v)); return v; }
__device__ __forceinline__ int lnd_s(int v) { v = __builtin_amdgcn_readfirstlane(v); asm volatile("" : "+s"(v)); return v; }
template <class Tp> __device__ __forceinline__ Tp* lnd_p(Tp* q) { const unsigned long long a = (unsigned long long)q; int lo = __builtin_amdgcn_readfirstlane((int)(unsigned)a), hi = __builtin_amdgcn_readfirstlane((int)(unsigned)(a >> 32));
    asm volatile("" : "+s"(lo), "+s"(hi)); return (Tp*)(((unsigned long long)(unsigned)hi << 32) | (unsigned long long)(unsigned)lo); }
#define TID() (lnd_s(wv_) * 64 + (int)__builtin_amdgcn_mbcnt_hi(~0u, __builtin_amdgcn_mbcnt_lo(~0u, (unsigned)lnd_s(0))))
#define BID() lnd_s((int)blockIdx.x)
#define NBLK() lnd_s((int)gridDim.x)
__device__ __forceinline__ unsigned cvt_pk_bf16(float lo, float hi) { unsigned r; asm volatile("v_cvt_pk_bf16_f32 %0, %1, %2" : "=v"(r) : "v"(lo), "v"(hi)); return r; }
__device__ __forceinline__ float bf2f(unsigned short h) { return __uint_as_float((unsigned)h << 16); }
__device__ __forceinline__ float bflo(unsigned w) { return __uint_as_float(w << 16); }
__device__ __forceinline__ float bfhi(unsigned w) { return __uint_as_float(w & 0xffff0000u); }
template <int K> __device__ __forceinline__ float shx(float v) {
    if constexpr (K == 32) { const auto rr = __builtin_amdgcn_permlane32_swap(__float_as_uint(v), __float_as_uint(v), false, false);
        const bool lo = (int)__builtin_amdgcn_mbcnt_hi(~0u, __builtin_amdgcn_mbcnt_lo(~0u, (unsigned)lnd_s(0))) < 32; return __uint_as_float(lo ? rr[1] : rr[0]); }
    else return __uint_as_float((unsigned)__builtin_amdgcn_ds_swizzle((int)__float_as_uint(v), (K << 10) | 0x1f));
}
__device__ __forceinline__ float shx_sum32(float v) { const auto rr = __builtin_amdgcn_permlane32_swap(__float_as_uint(v), __float_as_uint(v), false, false); return __uint_as_float(rr[0]) + __uint_as_float(rr[1]); }
__device__ __forceinline__ float shx_max32(float v) { const auto rr = __builtin_amdgcn_permlane32_swap(__float_as_uint(v), __float_as_uint(v), false, false); return fmaxf(__uint_as_float(rr[0]), __uint_as_float(rr[1])); }
__device__ __forceinline__ float wave_sum(float v) { v = shx_sum32(v); v += shx<16>(v); v += shx<8>(v); v += shx<4>(v); v += shx<2>(v); v += shx<1>(v); return v; }
__device__ __forceinline__ float wave_max(float v) { v = shx_max32(v); v = fmaxf(v, shx<16>(v)); v = fmaxf(v, shx<8>(v)); v = fmaxf(v, shx<4>(v)); v = fmaxf(v, shx<2>(v)); v = fmaxf(v, shx<1>(v)); return v; }

#define XB_TMO      128
#define XB_XCNT(j)  (256  + 64 * (j))
#define XB_XSUB(j)  (1280 + 64 * (j))
#define XB_XGEN(j)  (2304 + 64 * (j))
#define XB_TOP      3328
#define XB_TOPGEN   3392
#define XCD_BAR_WORDS 3456
#define XB_SPIN_CAP (1u << 18)
#define LAS __attribute__((address_space(3)))

__device__ __forceinline__ unsigned xb_ld(unsigned* p)              { return __hip_atomic_load(p, __ATOMIC_RELAXED, __HIP_MEMORY_SCOPE_AGENT); }
__device__ __forceinline__ unsigned xb_add(unsigned* p, unsigned v) { return __hip_atomic_fetch_add(p, v, __ATOMIC_RELAXED, __HIP_MEMORY_SCOPE_AGENT); }
__device__ __forceinline__ unsigned xb_xcc_id() { return (unsigned)__builtin_amdgcn_s_getreg((3 << 11) | 20) & 0xFu; }
#define XB_SPIN(cond, bar) do { unsigned _sp = 0; while (cond) { __builtin_amdgcn_s_sleep(1); \
    if ((++_sp & 255u) == 0u) { if (xb_ld(&(bar)[XB_TMO])) break; if (_sp > XB_SPIN_CAP) { atomicAdd(&(bar)[XB_TMO], 1u); break; } } } } while (0)

struct XcdBarrier { unsigned* bar; unsigned x; volatile LAS unsigned* st; };

__device__ __forceinline__ XcdBarrier xcd_barrier_post(unsigned* bar, volatile LAS unsigned* st, const bool t0) {
    XcdBarrier b; b.bar = bar; b.x = xb_xcc_id(); b.st = st;
    if (t0) (void)xb_add(&bar[XB_XCNT(b.x)], 1u);
    return b;
}
__device__ __forceinline__ void xcd_barrier_complete(unsigned* bar, unsigned x, unsigned& nloc, unsigned& nx) {
    const unsigned G = gridDim.x * gridDim.y * gridDim.z;
    unsigned sum, cnt, mine, sp = 0u;
    for (;;) {
        sum = 0u; cnt = 0u; mine = 0u;
#pragma unroll
        for (unsigned j = 0; j < 16; ++j) { const unsigned c = xb_ld(&bar[XB_XCNT(j)]); sum += c; cnt += (c > 0u) ? 1u : 0u; mine = (j == x) ? c : mine; }
        if (sum == G) break;
        __builtin_amdgcn_s_sleep(1);
        if ((++sp & 255u) == 0u) { if (xb_ld(&bar[XB_TMO])) break; if (sp > XB_SPIN_CAP) { atomicAdd(&bar[XB_TMO], 1u); break; } }
    }
    nloc = mine > 0u ? mine : 1u; nx = cnt > 0u ? cnt : 1u;
}
__device__ __forceinline__ void xcd_barrier(const XcdBarrier& b, const bool t0) {
    asm volatile("s_waitcnt vmcnt(0)" ::: "memory");
    __syncthreads();
    if (t0) {
        unsigned* bar = b.bar;
        __builtin_amdgcn_s_waitcnt(0);
        unsigned nloc = b.st[0], nx = b.st[1];
        if (nloc == 0u) { xcd_barrier_complete(bar, b.x, nloc, nx); b.st[0] = nloc; b.st[1] = nx; }
        const unsigned old = xb_add(&bar[XB_XSUB(b.x)], 1u);
        const unsigned gen = old / nloc;
        if (old + 1u == (gen + 1u) * nloc) {
            __builtin_amdgcn_fence(__ATOMIC_RELEASE, "agent");
            asm volatile("s_waitcnt vmcnt(0)" ::: "memory");
            const unsigned og = xb_add(&bar[XB_TOP], 1u);
            const unsigned tg = og / nx;
            if (og + 1u == (tg + 1u) * nx) xb_add(&bar[XB_TOPGEN], 1u);
            else XB_SPIN(xb_ld(&bar[XB_TOPGEN]) == tg, bar);
            __builtin_amdgcn_fence(__ATOMIC_ACQUIRE, "agent");
            xb_add(&bar[XB_XGEN(b.x)], 1u);
            asm volatile("s_waitcnt vmcnt(0)" ::: "memory");
        } else {
            XB_SPIN(xb_ld(&bar[XB_XGEN(b.x)]) == gen, bar);
            __builtin_amdgcn_fence(__ATOMIC_ACQUIRE, "agent");
            asm volatile("s_waitcnt vmcnt(0)" ::: "memory");
        }
    }
    __syncthreads();
}

struct GU { int pm, pn; const bf16_t* a; const bf16_t* b; };


namespace pg8 {
constexpr int BK = 64, HALF = 128, HTB = HALF * BK * 2, STAGE_BYTES = 8 * HTB;
__device__ __forceinline__ int lds_byte(int r, int c) { const int st = (r >> 4) * 2 + (c >> 5), rr = r & 15, cc = c & 31, ob = rr * 64 + cc * 2; return st * 1024 + (ob ^ (((ob >> 9) & 1) << 5)); }
__device__ __forceinline__ int perm32(int rho) { const int n = rho >> 4, i = rho & 15; return 8 * (i >> 2) + 4 * n + (i & 3); }
__device__ __forceinline__ void stage_rc(int b, int& R, int& C) { const int st = b / 1024, sb = b % 1024, swz = sb ^ (((sb >> 9) & 1) << 5); R = (st >> 1) * 16 + swz / 64; C = (st & 1) * 32 + (swz % 64) / 2; }

template <class Desc, class Epi>
__device__ __forceinline__ void gemm_phase(const int wv_, LAS unsigned char* lds, const Desc& d, const Epi& E) {
    const int tid = TID(), wid = __builtin_amdgcn_readfirstlane(tid >> 6), lane = tid & 63, wr = wid >> 2, wc = wid & 3, fr = lane & 15, fq = lane >> 4;
    const int nt = d.K / BK; int bid_ = BID(); const int nblk = NBLK();
    if constexpr (Desc::HAS_BID0) bid_ -= d.bid0;
    const int bid = bid_;
    unsigned voffA[2], voffA1[2], voffB[2]; int Rr[2], Cc[2];
    const size_t kstep = (size_t)(BK * 2);
    const size_t hstepA = (size_t)HALF * d.lda * 2, hstepB = (size_t)HALF * d.ldb * 2;
#pragma unroll
    for (int i = 0; i < 2; ++i) { int R, C; stage_rc(tid * 16 + i * 8192, R, C); const int Rb = (R & ~31) + perm32(R & 31); Rr[i] = R; Cc[i] = C;
        voffA[i] = (unsigned)(R * d.lda + C) * 2u; voffA1[i] = voffA[i] + (unsigned)hstepA; voffB[i] = (unsigned)(Rb * d.ldb + C) * 2u; }
    unsigned voffAn[2] = {0u, 0u}, voffAn1[2] = {0u, 0u};
    LAS unsigned short* const tix = (LAS unsigned short*)(lds + STAGE_BYTES + 16384);
#define PG8_AOFF(ord, U, O0, O1) do { _Pragma("unroll") for (int _i = 0; _i < 2; ++_i) { \
        O0[_i] = d.rowbyte(U, (int)tix[(ord) * 256 + Rr[_i]]) + (unsigned)(Cc[_i] * 2); O1[_i] = d.rowbyte(U, (int)tix[(ord) * 256 + HALF + Rr[_i]]) + (unsigned)(Cc[_i] * 2); } } while (0)
    const unsigned ldsw = (unsigned)wid * 1024u;
    const int aoff = lds_byte(wr * 64 + fr, fq * 8), boff = lds_byte(wc * 32 + fr, fq * 8);
#define PG8_SA(b, h) (((b) * 2 + (h)) * HTB)
#define PG8_SB(b, h) ((4 + (b) * 2 + (h)) * HTB)
#define PG8_STAGE(bufoff, gbase, voff) do { _Pragma("unroll") for (int _i = 0; _i < 2; ++_i) \
        __builtin_amdgcn_global_load_lds((const unsigned*)((const char*)(gbase) + (voff)[_i]), (LAS unsigned*)(lds + (bufoff) + ldsw + _i * 8192), 16, 0, 0); } while (0)
#define PG8_LDA(dst, b, h) do { _Pragma("unroll") for (int m = 0; m < 4; ++m) _Pragma("unroll") for (int k = 0; k < 2; ++k) dst[m][k] = *(const LAS bf16x8*)(lds + PG8_SA(b, h) + aoff + m * 2048 + k * 1024); } while (0)
#define PG8_LDB(dst, b, h) do { _Pragma("unroll") for (int n = 0; n < 2; ++n) _Pragma("unroll") for (int k = 0; k < 2; ++k) dst[n][k] = *(const LAS bf16x8*)(lds + PG8_SB(b, h) + boff + n * 2048 + k * 1024); } while (0)
#define PG8_MMA(ai, bj, At, Bt) do { __builtin_amdgcn_s_setprio(1); _Pragma("unroll") for (int m = 0; m < 4; ++m) _Pragma("unroll") for (int n = 0; n < 2; ++n) _Pragma("unroll") for (int k = 0; k < 2; ++k) \
        acc[ai][bj][m][n] = __builtin_amdgcn_mfma_f32_16x16x32_bf16(Bt[n][k], At[m][k], acc[ai][bj][m][n], 0, 0, 0); __builtin_amdgcn_s_setprio(0); } while (0)
#define PG8_WAIT_V(n) asm volatile("s_waitcnt vmcnt(" #n ")" ::: "memory")
#define PG8_WAIT_L(n) asm volatile("s_waitcnt lgkmcnt(" #n ")" ::: "memory")
#define PG8_BAR __builtin_amdgcn_s_barrier()
#define PG8_SCHED __builtin_amdgcn_sched_barrier(0)
    GU cur, nxt; int ui = 0;
    if (bid < 0 || bid >= d.nunits) return;
    LAS float* const rsc = (LAS float*)(lds + STAGE_BYTES);
    d.unit(bid, cur);
    const char* cA = (const char*)cur.a; const char* cB = (const char*)cur.b;
    PG8_STAGE(PG8_SB(0, 0), cB, voffB); PG8_STAGE(PG8_SB(0, 1), cB + hstepB, voffB);
    if constexpr (!Desc::GATHER) { PG8_STAGE(PG8_SA(0, 0), cA, voffA); PG8_STAGE(PG8_SA(0, 1), cA, voffA1); }
    if constexpr (Epi::STAGED || Desc::GATHER) {
        const int nmy = (d.nunits - bid + nblk - 1) / nblk;
        float sv[8]; int tv[8];
#pragma unroll
        for (int k = 0; k < 8; ++k) { const int idx = tid + NTHREADS * k; sv[k] = 0.f; tv[k] = 0;
            if (idx < nmy * 256) { GU su; d.unit(bid + (idx >> 8) * nblk, su);
                if constexpr (Epi::STAGED) sv[k] = E.rowscale(su, idx & 255);
                if constexpr (Desc::GATHER) tv[k] = d.tokidx(su, idx & 255); } }
#pragma unroll
        for (int k = 0; k < 8; ++k) { const int idx = tid + NTHREADS * k;
            if (idx < nmy * 256) { if constexpr (Epi::STAGED) rsc[idx] = sv[k]; if constexpr (Desc::GATHER) tix[idx] = (unsigned short)tv[k]; } }
        asm volatile("s_waitcnt vmcnt(0) lgkmcnt(0)" ::: "memory"); __builtin_amdgcn_s_barrier(); asm volatile("" ::: "memory");
    }
    if constexpr (Desc::GATHER) { PG8_AOFF(0, cur, voffA, voffA1); PG8_STAGE(PG8_SA(0, 0), cA, voffA); PG8_STAGE(PG8_SA(0, 1), cA, voffA1); }
    f32x4 acc[2][2][4][2];
#pragma unroll
    for (int a = 0; a < 2; ++a)
#pragma unroll
        for (int b = 0; b < 2; ++b)
#pragma unroll
            for (int m = 0; m < 4; ++m)
#pragma unroll
                for (int n = 0; n < 2; ++n) acc[a][b][m][n] = (f32x4){0.f, 0.f, 0.f, 0.f};
    bf16x8 At[4][2], B0[2][2], B1[2][2];
    if (wr == 1) PG8_BAR;
    PG8_WAIT_V(2); PG8_BAR;
    PG8_STAGE(PG8_SB(1, 0), cB + kstep, voffB); PG8_STAGE(PG8_SA(1, 0), cA + kstep, voffA); PG8_STAGE(PG8_SB(1, 1), cB + hstepB + kstep, voffB);
    PG8_WAIT_V(6); PG8_BAR;
    for (;;) {
        const int inext = bid + (ui + 1) * nblk; const bool has_next = inext < d.nunits;
        if (has_next) d.unit(inext, nxt);
        if constexpr (Desc::GATHER) { if (has_next) PG8_AOFF(ui + 1, nxt, voffAn, voffAn1); else { voffAn[0] = voffA[0]; voffAn[1] = voffA[1]; voffAn1[0] = voffA1[0]; voffAn1[1] = voffA1[1]; } }
        const char* nA = has_next ? (const char*)nxt.a : cA; const char* nB = has_next ? (const char*)nxt.b : cB;
        for (int t = 0; t < nt; t += 2) {
            const bool last = (t == nt - 2);
            unsigned sA0[2], sA1[2];
            if constexpr (Desc::GATHER) { sA0[0] = last ? voffAn[0] : voffA[0]; sA0[1] = last ? voffAn[1] : voffA[1]; sA1[0] = last ? voffAn1[0] : voffA1[0]; sA1[1] = last ? voffAn1[1] : voffA1[1]; }
            else { sA0[0] = voffA[0]; sA0[1] = voffA[1]; sA1[0] = voffA1[0]; sA1[1] = voffA1[1]; }
            const char* a1 = cA + (size_t)(t + 1) * kstep;
            const char* a2 = last ? nA : cA + (size_t)(t + 2) * kstep; const char* b2 = last ? nB : cB + (size_t)(t + 2) * kstep;
            const char* a3 = a2 + kstep; const char* b3 = b2 + kstep;
            PG8_LDB(B0, 0, 0); PG8_LDB(B1, 0, 1); PG8_SCHED; PG8_LDA(At, 0, 0); PG8_STAGE(PG8_SA(1, 1), a1, voffA1);
            PG8_WAIT_V(8); PG8_WAIT_L(0); PG8_BAR; PG8_MMA(0, 0, At, B0); PG8_MMA(0, 1, At, B1); PG8_BAR; PG8_SCHED;
            PG8_LDA(At, 0, 1); PG8_STAGE(PG8_SB(0, 0), b2, voffB); PG8_STAGE(PG8_SB(0, 1), b2 + hstepB, voffB); PG8_STAGE(PG8_SA(0, 0), a2, sA0);
            PG8_WAIT_V(8); PG8_WAIT_L(0); PG8_BAR; PG8_MMA(1, 0, At, B0); PG8_MMA(1, 1, At, B1); PG8_BAR; PG8_SCHED;
            PG8_LDB(B0, 1, 0); PG8_LDB(B1, 1, 1); PG8_SCHED; PG8_LDA(At, 1, 0); PG8_STAGE(PG8_SA(0, 1), a2, sA1);
            PG8_WAIT_V(8); PG8_WAIT_L(0); PG8_BAR; PG8_MMA(0, 0, At, B0); PG8_MMA(0, 1, At, B1); PG8_BAR; PG8_SCHED;
            PG8_LDA(At, 1, 1); PG8_STAGE(PG8_SB(1, 0), b3, voffB); PG8_STAGE(PG8_SB(1, 1), b3 + hstepB, voffB); PG8_STAGE(PG8_SA(1, 0), a3, sA0);
            PG8_WAIT_V(8); PG8_WAIT_L(0); PG8_BAR; PG8_MMA(1, 0, At, B0); PG8_MMA(1, 1, At, B1); PG8_BAR; PG8_SCHED;
        }
        if (wr == 0) PG8_BAR;
        E(acc, cur, wr, wc, fr, fq, rsc + ui * 256);
        if (!has_next) break;
#pragma unroll
        for (int a = 0; a < 2; ++a)
#pragma unroll
            for (int b = 0; b < 2; ++b)
#pragma unroll
                for (int m = 0; m < 4; ++m)
#pragma unroll
                    for (int n = 0; n < 2; ++n) acc[a][b][m][n] = (f32x4){0.f, 0.f, 0.f, 0.f};
        cur = nxt; cA = nA; cB = nB; ++ui;
        if constexpr (Desc::GATHER) { voffA[0] = voffAn[0]; voffA[1] = voffAn[1]; voffA1[0] = voffAn1[0]; voffA1[1] = voffAn1[1]; }
        if (wr == 1) PG8_BAR;
    }
    PG8_WAIT_V(0);
    PG8_BAR;
#undef PG8_AOFF
#undef PG8_SA
#undef PG8_SB
#undef PG8_STAGE
#undef PG8_LDA
#undef PG8_LDB
#undef PG8_MMA
#undef PG8_WAIT_V
#undef PG8_WAIT_L
#undef PG8_BAR
#undef PG8_SCHED
}
}
#ifndef GEMM_SIMPLE
#define GEMM_SIMPLE 0
#endif
#define GEMM(lds, d, E) pg8::gemm_phase(wv_, (LAS unsigned char*)(lds), d, E)

#define ACC_T const f32x4 (&acc)[2][2][4][2]
#define FOR_ACC _Pragma("unroll") for (int ai = 0; ai < 2; ++ai) _Pragma("unroll") for (int m = 0; m < 4; ++m) _Pragma("unroll") for (int bj = 0; bj < 2; ++bj) _Pragma("unroll") for (int n = 0; n < 2; ++n)
#define RLOC_OF (ai * 128 + wr * 64 + m * 16 + fr)
#define ROW_OF (u.pm * 256 + RLOC_OF)
#define COL_OF (u.pn * 256 + bj * 128 + wc * 32 + fq * 8 + n * 4)

__device__ __forceinline__ int xcd_major(int i, int nunits) { const int rd = i >> 8, b = i & 255; return ((rd + 1) * 256 <= nunits) ? (((rd * 8 + (b & 7)) << 5) + (b >> 3)) : i; }
struct DescPlain {
    static constexpr bool HAS_BID0 = false;
    static constexpr bool GATHER = false;
    const bf16_t* A; const bf16_t* Bt; int lda, ldb, K, nM, nN, nunits;
    __device__ __forceinline__ void unit(int i0, GU& u) const { const int i = xcd_major(i0, nunits); u.pm = i / nN; u.pn = i % nN; u.a = A + (size_t)u.pm * 256 * lda; u.b = Bt + (size_t)u.pn * 256 * ldb; }
};
struct DescKV {
    static constexpr bool HAS_BID0 = false;
    static constexpr bool GATHER = false;
    const bf16_t* mb; const bf16_t* Wk; const bf16_t* Wv; int lda, ldb, K, nunits;
    __device__ __forceinline__ void unit(int i, GU& u) const { const int which = i >> 7, r = i & 127, pml = r >> 2; u.pn = r & 3; const int l = pml >> 3; u.pm = which * 32 + pml;
        u.a = mb + (size_t)pml * 256 * 1024; u.b = (which ? Wv : Wk) + ((size_t)l * 1024 + u.pn * 256) * 1024; }
};
struct DescMt {
    static constexpr bool GATHER = false;
    static constexpr bool HAS_BID0 = true; const bf16_t* kx; const bf16_t* wq; int lda, ldb, K, nunits, lbase, bid0;
    __device__ __forceinline__ void unit(int i0, GU& u) const { const int i = i0 + lbase, l = i >> 7, r = i & 127, b = r >> 4, h = (r >> 2) & 3, nt = r & 3; u.pm = (l * NB + b) * 4 + h; u.pn = nt;
        u.a = kx + ((size_t)l * 2048 + b * 256) * 1024 + h * 256; u.b = wq + ((size_t)l * 1024 + nt * 256) * 1024 + h * 256; }
};
struct DescNt {
    static constexpr bool GATHER = false;
    static constexpr bool HAS_BID0 = true; const bf16_t* woT; const bf16_t* vx; int lda, ldb, K, nunits, lbase, bid0;
    __device__ __forceinline__ void unit(int i0, GU& u) const { const int i = i0 + lbase, l = i >> 7, r = i & 127, b = r >> 4, h = (r >> 2) & 3, nt = r & 3; u.pm = (l * NB + b) * 4 + nt; u.pn = h;
        u.a = woT + ((size_t)l * 1024 + nt * 256) * 1024 + h * 256; u.b = vx + ((size_t)l * 2048 + b * 256) * 1024 + h * 256; }
};
struct DescXB {
    static constexpr bool HAS_BID0 = false;
    static constexpr bool GATHER = false;
    static constexpr int STAGGER_TICKS = 0; const bf16_t* A; const bf16_t* Bt; int lda, ldb, K, nunits;
    __device__ __forceinline__ void unit(int i0, GU& u) const { const int i = xcd_major(i0, nunits); u.pm = i >> 2; u.pn = i & 3; const int b = u.pm >> 4;
        u.a = A + (size_t)u.pm * 256 * 1024; u.b = Bt + ((size_t)(b * 4 + u.pn) * 256) * 1024; }
};
struct DescGU {
    static constexpr bool HAS_BID0 = false;
    static constexpr bool GATHER = true;
    const bf16_t* xb; const int* tok; const bf16_t* W; int lda, ldb, K, nunits, base;
    __device__ __forceinline__ void unit(int i0, GU& u) const { const int i = i0 + base, e = i >> 8, j = i & 255, x = j & 7, r = j >> 3, pmi = (x >> 1) * 4 + (r >> 3); u.pn = (x & 1) * 8 + (r & 7); u.pm = ((pmi >> 1) * NE + e) * 2 + (pmi & 1);
        u.a = xb; u.b = W + ((size_t)e * 4096 + u.pn * 256) * 1024; }
    __device__ __forceinline__ int tokidx(const GU& u, int r) const { return tok[u.pm * 256 + r]; }
    __device__ __forceinline__ unsigned rowbyte(const GU& u, int sidx) const { return (unsigned)(((u.pm >> 5) * SEQ + sidx) * (DM * 2)); }
};
struct DescDown {
    static constexpr bool HAS_BID0 = false;
    static constexpr bool GATHER = false;
    const bf16_t* act; const bf16_t* W; int lda, ldb, K, nunits;
    __device__ __forceinline__ void unit(int i, GU& u) const { const int rd = i >> 8, j = i & 255, x = j & 7, r = j >> 3, e = NE - 1 - (rd * 4 + (x >> 1)), pmi = (x & 1) * 8 + (r >> 2);     u.pn = r & 3; u.pm = ((pmi >> 1) * NE + e) * 2 + (pmi & 1);
        u.a = act + (size_t)u.pm * 256 * 2048; u.b = W + ((size_t)e * 1024 + u.pn * 256) * 2048; }
};

__device__ __forceinline__ void st_bf16x4(bf16_t* p, f32x4 v) { u32x2 w; w.x = cvt_pk_bf16(v[0], v[1]); w.y = cvt_pk_bf16(v[2], v[3]); *(u32x2*)p = w; }

__device__ __forceinline__ void st_bf16x8(bf16_t* p, f32x4 a, f32x4 b) { u32x4 w; w.x = cvt_pk_bf16(a[0], a[1]); w.y = cvt_pk_bf16(a[2], a[3]); w.z = cvt_pk_bf16(b[0], b[1]); w.w = cvt_pk_bf16(b[2], b[3]); *(u32x4*)p = w; }
#define COL8_OF (u.pn * 256 + bj * 128 + wc * 32 + fq * 8)
struct EpiBf16 {
    bf16_t* O; int ldc; const float* rs; float scale; static constexpr bool STAGED = true;
    __device__ __forceinline__ float rowscale(const GU& u, int r) const { return (rs ? rs[u.pm * 256 + r] : 1.f) * scale; }
    __device__ __forceinline__ void operator()(ACC_T, const GU& u, int wr, int wc, int fr, int fq, const LAS float* sc) const {
#pragma unroll
        for (int ai = 0; ai < 2; ++ai)
#pragma unroll
            for (int m = 0; m < 4; ++m) { const int row = ROW_OF; const float s = sc[RLOC_OF];
#pragma unroll
                for (int bj = 0; bj < 2; ++bj) st_bf16x8(O + (size_t)row * ldc + COL8_OF, acc[ai][bj][m][0] * s, acc[ai][bj][m][1] * s); }
    }
};
struct EpiResid {
    const bf16_t* xin; bf16_t* xout; float* ssp; static constexpr bool STAGED = false;
    __device__ __forceinline__ void operator()(ACC_T, const GU& u, int wr, int wc, int fr, int fq, const LAS float* sc) const {
#pragma unroll
        for (int ai = 0; ai < 2; ++ai)
#pragma unroll
            for (int m = 0; m < 4; ++m) { const int row = ROW_OF; float ss = 0.f;
#pragma unroll
                for (int bj = 0; bj < 2; ++bj) { const size_t o = (size_t)row * 1024 + COL8_OF; const u32x4 xi = *(const u32x4*)(xin + o);
                        const f32x4 v0 = (f32x4){bflo(xi.x), bfhi(xi.x), bflo(xi.y), bfhi(xi.y)} + acc[ai][bj][m][0], v1 = (f32x4){bflo(xi.z), bfhi(xi.z), bflo(xi.w), bfhi(xi.w)} + acc[ai][bj][m][1];
                        st_bf16x8(xout + o, v0, v1);
                        ss += ((v0[0] * v0[0] + v0[1] * v0[1]) + (v0[2] * v0[2] + v0[3] * v0[3])) + ((v1[0] * v1[0] + v1[1] * v1[1]) + (v1[2] * v1[2] + v1[3] * v1[3])); }
                if (ssp) { ss += shx<16>(ss); ss = shx_sum32(ss); if (fq == 0) ssp[(size_t)row * 16 + u.pn * 4 + wc] = ss; } }
    }
};
struct EpiQ {
    bf16_t* Qf; const float* rsq; const f32x2* cs; static constexpr bool STAGED = true;
    __device__ __forceinline__ float rowscale(const GU& u, int r) const { return rsq[u.pm * 256 + r]; }
    __device__ __forceinline__ void operator()(ACC_T, const GU& u, int wr, int wc, int fr, int fq, const LAS float* sc) const {
#pragma unroll
        for (int ai = 0; ai < 2; ++ai)
#pragma unroll
            for (int m = 0; m < 4; ++m) { const int row = ROW_OF; const float s = sc[RLOC_OF]; const int b = row >> 12, sq = row & 4095;
#pragma unroll
                for (int bj = 0; bj < 2; ++bj)
#pragma unroll
                    for (int n = 0; n < 2; ++n) { const int col = COL_OF, h = col / 192, j = col - h * 192; f32x4 v = acc[ai][bj][m][n] * s;
                        if (j >= 128) { const int p0 = (j - 128) >> 1; const f32x4 c2 = *(const f32x4*)(cs + (size_t)row * 32 + p0);
                            const f32x4 r = {v[0] * c2[0] - v[1] * c2[1], v[0] * c2[1] + v[1] * c2[0], v[2] * c2[2] - v[3] * c2[3], v[2] * c2[3] + v[3] * c2[2]}; v = r; }
                        st_bf16x4(Qf + ((size_t)(b * NH + h) * SEQ + sq) * DQK + j, v); } }
    }
};
struct EpiSoftmax {
    bf16_t* P; LAS float* xs; const float* ssp; float scale;
    static constexpr bool STAGED = true;
    __device__ __forceinline__ float rowscale(const GU& u, int r) const { const f32x4* sp = (const f32x4*)(ssp + (size_t)(u.pm * 256 + r) * 16); const f32x4 a = sp[0], b = sp[1], c = sp[2], d = sp[3];
        const float ss = ((a[0] + a[1]) + (a[2] + a[3])) + ((b[0] + b[1]) + (b[2] + b[3])) + ((c[0] + c[1]) + (c[2] + c[3])) + ((d[0] + d[1]) + (d[2] + d[3])); return rsqrtf(ss * (1.0f / 1024.0f) + EPS) * scale; }
    __device__ __forceinline__ void operator()(f32x4 (&acc)[2][2][4][2], const GU& u, int wr, int wc, int fr, int fq, const LAS float* sc) const {
#pragma unroll
        for (int ai = 0; ai < 2; ++ai)
#pragma unroll
            for (int m = 0; m < 4; ++m) { float mx = -3.0e38f; const float s = sc[RLOC_OF];
#pragma unroll
                for (int bj = 0; bj < 2; ++bj)
#pragma unroll
                    for (int n = 0; n < 2; ++n) { const f32x4 v = acc[ai][bj][m][n] * s; acc[ai][bj][m][n] = v; mx = fmaxf(mx, fmaxf(fmaxf(v[0], v[1]), fmaxf(v[2], v[3]))); }
                mx = fmaxf(mx, shx<16>(mx)); mx = shx_max32(mx);
                if (fq == 0) xs[(ai * 128 + wr * 64 + m * 16 + fr) * 4 + wc] = mx; }
        asm volatile("s_waitcnt lgkmcnt(0)" ::: "memory"); __builtin_amdgcn_s_barrier(); asm volatile("" ::: "memory");
#pragma unroll
        for (int ai = 0; ai < 2; ++ai)
#pragma unroll
            for (int m = 0; m < 4; ++m) { const int rl = ai * 128 + wr * 64 + m * 16 + fr; const f32x4 r4 = *(const LAS f32x4*)(xs + rl * 4);
                const float M = fmaxf(fmaxf(r4[0], r4[1]), fmaxf(r4[2], r4[3])); float sum = 0.f;
#pragma unroll
                for (int bj = 0; bj < 2; ++bj)
#pragma unroll
                    for (int n = 0; n < 2; ++n) { f32x4 v = acc[ai][bj][m][n];
#pragma unroll
                        for (int q = 0; q < 4; ++q) { v[q] = __expf(v[q] - M); sum += v[q]; }
                        acc[ai][bj][m][n] = v; }
                sum += shx<16>(sum); sum = shx_sum32(sum);
                if (fq == 0) xs[1024 + rl * 4 + wc] = sum; }
        asm volatile("s_waitcnt lgkmcnt(0)" ::: "memory"); __builtin_amdgcn_s_barrier(); asm volatile("" ::: "memory");
#pragma unroll
        for (int ai = 0; ai < 2; ++ai)
#pragma unroll
            for (int m = 0; m < 4; ++m) { const int rl = ai * 128 + wr * 64 + m * 16 + fr; const f32x4 r4 = *(const LAS f32x4*)(xs + 1024 + rl * 4);
                const float inv = 1.f / ((r4[0] + r4[1]) + (r4[2] + r4[3])); const int row = u.pm * 256 + rl;
#pragma unroll
                for (int bj = 0; bj < 2; ++bj) st_bf16x8(P + (size_t)row * 1024 + COL8_OF, acc[ai][bj][m][0] * inv, acc[ai][bj][m][1] * inv); }
    }
};
struct EpiSwiglu {
    bf16_t* act; const float* rsrow; static constexpr bool STAGED = true;
    __device__ __forceinline__ float rowscale(const GU& u, int r) const { return rsrow[u.pm * 256 + r]; }
    __device__ __forceinline__ void operator()(ACC_T, const GU& u, int wr, int wc, int fr, int fq, const LAS float* sc) const {
#pragma unroll
        for (int ai = 0; ai < 2; ++ai)
#pragma unroll
            for (int m = 0; m < 4; ++m) { const int row = ROW_OF; const float s = sc[RLOC_OF];
                f32x4 o[2];
#pragma unroll
                for (int n = 0; n < 2; ++n) { const f32x4 g = acc[ai][0][m][n] * s, up = acc[ai][1][m][n] * s;
#pragma unroll
                    for (int q = 0; q < 4; ++q) o[n][q] = g[q] * __builtin_amdgcn_rcpf(1.f + __expf(-g[q])) * up[q]; }
                st_bf16x8(act + (size_t)row * DE + u.pn * 128 + wc * 32 + fq * 8, o[0], o[1]); }
    }
};

namespace att {
constexpr int NW = 8, QBLK = 32, KVBLK = 64;
constexpr float SCALE = 0.07216878364870322f;
constexpr float THR = 8.f;
constexpr int LDQ = DQK, LDK = DQK, LDV = DQK, LDO = 1024;
constexpr int SHM_V = KVBLK * DV * 2, SHM_K = KVBLK * 400, SHM_ATTN = 2 * SHM_K + NW * 64 * 4;
#define KPITCH 400
#define KSWZ(row, colB) ((row) * KPITCH + (colB))
#define SBAR() __builtin_amdgcn_sched_barrier(0)
__device__ __forceinline__ int crow(int r, int hi) { return (r & 3) + 8 * (r >> 2) + 4 * hi; }
__device__ __forceinline__ void partialSM(f32x16& p0, f32x16& p1, float& m_reg, float& mn, float& alpha) {
    constexpr float C = SCALE * 1.4426950408889634f;
    float pmax = p0[0];
#pragma unroll
    for (int r = 1; r < 16; ++r) pmax = fmaxf(pmax, p0[r]);
#pragma unroll
    for (int r = 0; r < 16; ++r) pmax = fmaxf(pmax, p1[r]);
    { auto rr = __builtin_amdgcn_permlane32_swap(__float_as_uint(pmax), __float_as_uint(pmax), false, false);
      pmax = fmaxf(__uint_as_float(rr[0]), __uint_as_float(rr[1])); }
    if (__builtin_expect(__all(pmax - m_reg <= THR / SCALE), 1)) { mn = m_reg; alpha = 1.f; }
    else { mn = fmaxf(m_reg, pmax); alpha = __builtin_amdgcn_exp2f((m_reg - mn) * C); m_reg = mn; }
    const float mnC = -mn * C;
#pragma unroll
    for (int r = 0; r < 16; ++r) p0[r] = fmaf(p0[r], C, mnC);
#pragma unroll
    for (int r = 0; r < 16; ++r) p1[r] = fmaf(p1[r], C, mnC);
#pragma unroll
    for (int r = 0; r < 16; ++r) p0[r] = __builtin_amdgcn_exp2f(p0[r]);
}
__device__ __forceinline__ void finishSM(f32x16& p0, f32x16& p1, float alpha, float& l_reg, bf16x8& pa0, bf16x8& pa1, bf16x8& pa2, bf16x8& pa3) {
#pragma unroll
    for (int r = 0; r < 16; ++r) p1[r] = __builtin_amdgcn_exp2f(p1[r]);
    float ps = 0;
#pragma unroll
    for (int r = 0; r < 16; ++r) ps += p0[r];
#pragma unroll
    for (int r = 0; r < 16; ++r) ps += p1[r];
    { auto rr = __builtin_amdgcn_permlane32_swap(__float_as_uint(ps), __float_as_uint(ps), false, false);
      ps = __uint_as_float(rr[0]) + __uint_as_float(rr[1]); }
    l_reg = l_reg * alpha + ps;
#define PK4(P, BASE, OUT) do { unsigned a0 = cvt_pk_bf16(P[BASE + 0], P[BASE + 1]), a1 = cvt_pk_bf16(P[BASE + 2], P[BASE + 3]);   \
    unsigned b0 = cvt_pk_bf16(P[BASE + 4], P[BASE + 5]), b1 = cvt_pk_bf16(P[BASE + 6], P[BASE + 7]);                              \
    auto r0 = __builtin_amdgcn_permlane32_swap(a0, b0, false, false); auto r1 = __builtin_amdgcn_permlane32_swap(a1, b1, false, false); \
    u32x4 w = {r0[0], r1[0], r0[1], r1[1]}; OUT = *reinterpret_cast<bf16x8*>(&w); } while (0)
    PK4(p0, 0, pa0); PK4(p0, 8, pa1); PK4(p1, 0, pa2); PK4(p1, 8, pa3);
#undef PK4
}
template <int OFF> __device__ __forceinline__ bf16x8 k_read(int kb) { bf16x8 r; asm volatile("ds_read_b128 %0, %1 offset:%2" : "=&v"(r) : "v"(kb), "i"(OFF) : "memory"); return r; }
#define K_WAIT(N, A, B) asm volatile("s_waitcnt lgkmcnt(" #N ")" : "+v"(A), "+v"(B) :: "memory")
__device__ __forceinline__ void qkt(f32x16& p0, f32x16& p1, const unsigned char* Ks, const bf16x8* qr, int r32, int hi) {
    const int kb = (int)(uintptr_t)Ks + r32 * KPITCH + hi * 16;
    constexpr int R1 = 32 * KPITCH;
    p0 = f32x16{}; p1 = f32x16{};
    bf16x8 a0 = k_read<0>(kb), a1 = k_read<R1>(kb), a2 = k_read<32>(kb), a3 = k_read<R1 + 32>(kb), a4 = k_read<64>(kb), a5 = k_read<R1 + 64>(kb);
#define QK_STEP(D, X, Y, NEXT, N) do { K_WAIT(N, X, Y); \
        p0 = __builtin_amdgcn_mfma_f32_32x32x16_bf16(X, qr[D], p0, 0, 0, 0); p1 = __builtin_amdgcn_mfma_f32_32x32x16_bf16(Y, qr[D], p1, 0, 0, 0); \
        if constexpr ((NEXT) < 12) { X = k_read<(NEXT) * 32>(kb); Y = k_read<R1 + (NEXT) * 32>(kb); } } while (0)
    QK_STEP(0, a0, a1, 3, 4); QK_STEP(1, a2, a3, 4, 4); QK_STEP(2, a4, a5, 5, 4);
    QK_STEP(3, a0, a1, 6, 4); QK_STEP(4, a2, a3, 7, 4); QK_STEP(5, a4, a5, 8, 4);
    QK_STEP(6, a0, a1, 9, 4); QK_STEP(7, a2, a3, 10, 4); QK_STEP(8, a4, a5, 11, 4);
    QK_STEP(9, a0, a1, 12, 4); QK_STEP(10, a2, a3, 12, 2); QK_STEP(11, a4, a5, 12, 0);
#undef QK_STEP
}
__device__ __forceinline__ int v_st(int k, int c) { const int kk = (k & ~0xC) | ((k & 4) << 1) | ((k & 8) >> 1); return ((kk >> 3) * 4 + (c >> 5)) * 512 + ((kk & 7) * 32 + (c & 31)) * 2; }
__device__ __forceinline__ int v_rd_base(int lane) { const int g = lane >> 4, c = lane & 15; return (8 * (g >> 1) + (c >> 2)) * KPITCH + (16 * (g & 1) + 4 * (c & 3)) * 2; }
constexpr int v_rd_off(int d0, int ks, int half) { return d0 * 64 + ks * (16 * KPITCH) + half * (4 * KPITCH); }
template <int OFF> __device__ __forceinline__ s16x4 tr_read(int vb) {
    s16x4 r; asm volatile("ds_read_b64_tr_b16 %0, %1 offset:%2" : "=&v"(r) : "v"(vb), "i"(OFF) : "memory"); return r;
}
#define PV_READ(D0, L0, H0, L1, H1, L2, H2, L3, H3) do { L0 = tr_read<v_rd_off(D0, 0, 0)>(vb); H0 = tr_read<v_rd_off(D0, 0, 1)>(vb); L1 = tr_read<v_rd_off(D0, 1, 0)>(vb); H1 = tr_read<v_rd_off(D0, 1, 1)>(vb); \
    L2 = tr_read<v_rd_off(D0, 2, 0)>(vb); H2 = tr_read<v_rd_off(D0, 2, 1)>(vb); L3 = tr_read<v_rd_off(D0, 3, 0)>(vb); H3 = tr_read<v_rd_off(D0, 3, 1)>(vb); } while (0)
#define PK(L, H) (bf16x8){L[0], L[1], L[2], L[3], H[0], H[1], H[2], H[3]}
#define PV_MMA(od, L0, H0, L1, H1, L2, H2, L3, H3) do { od = __builtin_amdgcn_mfma_f32_32x32x16_bf16(pa0, PK(L0, H0), od, 0, 0, 0); od = __builtin_amdgcn_mfma_f32_32x32x16_bf16(pa1, PK(L1, H1), od, 0, 0, 0); \
    od = __builtin_amdgcn_mfma_f32_32x32x16_bf16(pa2, PK(L2, H2), od, 0, 0, 0); od = __builtin_amdgcn_mfma_f32_32x32x16_bf16(pa3, PK(L3, H3), od, 0, 0, 0); } while (0)
__device__ __forceinline__ void pv_d0(f32x16* o, int vb, bf16x8 pa0, bf16x8 pa1, bf16x8 pa2, bf16x8 pa3) {
    s16x4 a0, a1, a2, a3, a4, a5, a6, a7, b0, b1, b2, b3, b4, b5, b6, b7;
    PV_READ(0, a0, a1, a2, a3, a4, a5, a6, a7);
    PV_READ(1, b0, b1, b2, b3, b4, b5, b6, b7);
    asm volatile("s_waitcnt lgkmcnt(8)" ::: "memory"); SBAR();
    PV_MMA(o[0], a0, a1, a2, a3, a4, a5, a6, a7); SBAR();
    PV_READ(2, a0, a1, a2, a3, a4, a5, a6, a7);
    asm volatile("s_waitcnt lgkmcnt(8)" ::: "memory"); SBAR();
    PV_MMA(o[1], b0, b1, b2, b3, b4, b5, b6, b7); SBAR();
    PV_READ(3, b0, b1, b2, b3, b4, b5, b6, b7);
    asm volatile("s_waitcnt lgkmcnt(8)" ::: "memory"); SBAR();
    PV_MMA(o[2], a0, a1, a2, a3, a4, a5, a6, a7); SBAR();
    asm volatile("s_waitcnt lgkmcnt(0)" ::: "memory"); SBAR();
    PV_MMA(o[3], b0, b1, b2, b3, b4, b5, b6, b7);
}
#undef PK
template <int VAR> __device__ __forceinline__ void attn_dense_body(const int wv_, const bf16_t* __restrict__ Qb, const bf16_t* __restrict__ Kh, const bf16_t* __restrict__ Vh, bf16_t* __restrict__ Ob, int seq, unsigned char* lds) {
    const int tid = TID(), wid = tid >> 6, lane = tid & 63, r32 = lane & 31, hi = lane >> 5;
    unsigned char* K_lds = lds;
    float* ws = (float*)(lds + 2 * SHM_K) + wid * 64; float* li_l = ws; float* al_l = ws + 32;
    float m_reg = -1e30f, l_reg = 0; f32x16 o[4] = {}; bf16x8 qr[12];
    const bf16_t* Qw = Qb + (long)(wid * QBLK + r32) * LDQ + hi * 8;
#pragma unroll
    for (int d0 = 0; d0 < 12; ++d0) qr[d0] = *(const bf16x8*)(Qw + d0 * 16);
    int kg[3], kl[3];
#pragma unroll
    for (int i = 0; i < 3; ++i) { const int id = tid + 512 * i, row = id / 24, ch = id % 24; kg[i] = row * LDK + ch * 8; kl[i] = KSWZ(row, ch * 16); }
    const int vb0 = (int)(uintptr_t)K_lds + v_rd_base(lane);
    bf16x8 ks0, ks1, ks2;
#define SLOAD(k0) do { \
    ks0 = *(const bf16x8*)(&Kh[(long)(k0) * LDK + kg[0]]); ks1 = *(const bf16x8*)(&Kh[(long)(k0) * LDK + kg[1]]); ks2 = *(const bf16x8*)(&Kh[(long)(k0) * LDK + kg[2]]); } while (0)
#define SWRITE(b) do { \
    *(bf16x8*)(K_lds + (b) * SHM_K + kl[0]) = ks0; *(bf16x8*)(K_lds + (b) * SHM_K + kl[1]) = ks1; *(bf16x8*)(K_lds + (b) * SHM_K + kl[2]) = ks2; } while (0)
#define SWAIT() asm volatile("s_waitcnt vmcnt(0)" ::: "memory")
#define RESC(a) do { if (__any((a) < 1.f)) { if (hi == 0) al_l[r32] = (a); asm volatile("s_waitcnt lgkmcnt(0)" ::: "memory"); \
    _Pragma("unroll") for (int d = 0; d < 4; ++d) _Pragma("unroll") for (int r = 0; r < 16; ++r) o[d][r] *= al_l[crow(r, hi)]; } } while (0)
    f32x16 p0, p1; float mn, al; bf16x8 pa0, pa1, pa2, pa3; const int NT = seq / KVBLK;
    SLOAD(0); SWAIT(); SWRITE(0); SLOAD(KVBLK);
    for (int j = 0; j < NT; ++j) {
        __syncthreads();
        if (j + 1 < NT) { SWAIT(); SWRITE((j + 1) & 1); if (j + 2 < NT) SLOAD((j + 2) * KVBLK); }
        const int bsel = j & 1;
        if constexpr (VAR != 3) qkt(p0, p1, K_lds + bsel * SHM_K, qr, r32, hi); else { p0 = o[0] * 0.5f; p1 = o[1] * 0.25f; }
        if constexpr (VAR != 2) { partialSM(p0, p1, m_reg, mn, al);
        RESC(al);
        finishSM(p0, p1, al, l_reg, pa0, pa1, pa2, pa3); SBAR(); }
        else { u32x4 w0 = {__float_as_uint(p0[0]), __float_as_uint(p0[1]), __float_as_uint(p0[2]), __float_as_uint(p0[3])}, w1 = {__float_as_uint(p0[4]), __float_as_uint(p1[1]), __float_as_uint(p1[2]), __float_as_uint(p1[3])};
               pa0 = *reinterpret_cast<bf16x8*>(&w0); pa1 = *reinterpret_cast<bf16x8*>(&w1); pa2 = pa0; pa3 = pa1; l_reg += p0[5] + p1[7] + p0[9] + p1[11] + p0[13] + p1[15] + p0[6] + p1[8] + p0[10] + p1[12] + p0[14] + p1[0] + p0[7] + p0[8] + p0[11] + p0[12] + p0[15] + p1[4] + p1[5] + p1[6] + p1[9] + p1[10] + p1[13] + p1[14]; SBAR(); }
        if constexpr (VAR != 1) pv_d0(o, vb0 + bsel * SHM_K, pa0, pa1, pa2, pa3); else { o[0][0] += __uint_as_float((unsigned)pa0[0] << 16) + __uint_as_float((unsigned)pa1[1] << 16) + __uint_as_float((unsigned)pa2[2] << 16) + __uint_as_float((unsigned)pa3[3] << 16); }
    }
    if (hi == 0) li_l[r32] = l_reg; asm volatile("s_waitcnt lgkmcnt(0)" ::: "memory");
    float rli[16];
#pragma unroll
    for (int r = 0; r < 16; ++r) rli[r] = __builtin_amdgcn_rcpf(li_l[crow(r, hi)]);
    bf16_t* Ow = Ob + (long)(wid * QBLK) * LDO;
    unsigned char* ost = lds + 90112 + wid * 8704;
#pragma unroll
    for (int r = 0; r < 16; ++r) { const int orow = crow(r, hi);
#pragma unroll
        for (int d0 = 0; d0 < 4; ++d0) *(bf16_t*)(ost + orow * 272 + (d0 * 32 + r32) * 2) = (bf16_t)(cvt_pk_bf16(o[d0][r] * rli[r], 0.f) & 0xffffu); }
    asm volatile("s_waitcnt lgkmcnt(0)" ::: "memory");
#pragma unroll
    for (int i = 0; i < 8; ++i) { const int row = (lane >> 4) + 4 * i; const u32x4 w = *(const u32x4*)(ost + row * 272 + (lane & 15) * 16); *(u32x4*)(Ow + (long)row * LDO + (lane & 15) * 8) = w; }
    __syncthreads();
#undef SLOAD
#undef SWRITE
#undef SWAIT
#undef RESC
}
}

__device__ __forceinline__ void sincos_acc(float af, float& c, float& s) {
    const double a = (double)af;
    const double kq = rint(a * 0.63661977236758134308);
    double r = fma(-kq, 1.5707963267948966, a); r = fma(-kq, 6.123233995736766e-17, r);
    const int q = ((int)kq) & 3;
    const double r2 = r * r;
    double sp = -1.0 / 6227020800.0 * -1.0;
    sp = fma(sp, r2, -1.0 / 39916800.0); sp = fma(sp, r2, 1.0 / 362880.0); sp = fma(sp, r2, -1.0 / 5040.0); sp = fma(sp, r2, 1.0 / 120.0); sp = fma(sp, r2, -1.0 / 6.0); sp = fma(sp, r2, 1.0);
    const double sr = sp * r;
    double cp = -1.0 / 87178291200.0;
    cp = fma(cp, r2, 1.0 / 479001600.0); cp = fma(cp, r2, -1.0 / 3628800.0); cp = fma(cp, r2, 1.0 / 40320.0); cp = fma(cp, r2, -1.0 / 720.0); cp = fma(cp, r2, 1.0 / 24.0); cp = fma(cp, r2, -0.5); cp = fma(cp, r2, 1.0);
    const double cr = cp;
    double cc, ssn;
    if (q == 0) { cc = cr; ssn = sr; } else if (q == 1) { cc = -sr; ssn = cr; } else if (q == 2) { cc = -cr; ssn = -sr; } else { cc = sr; ssn = -cr; }
    c = (float)cc; s = (float)ssn;
}

__device__ __forceinline__ void conv_job(const int wv_, unsigned char* lds, const float* src, const float* src2, int ldsrc, int coff, bf16_t* dst, int K, int ndst, const float* gk, const float* sn, int mode) {
    float* tile = (float*)lds;
    const int tid = TID(), tk = K / 64, tn = ndst / 64, ntile = tk * tn;
    for (int t = BID(); t < ntile; t += NBLK()) {
        const int nb = (t / tk) * 64, kb = (t % tk) * 64;
        if (mode == 1 && (nb % 192) < 128) continue;
        const int nl = tid & 63, np = nb + nl;
        const float* sp = src; int col = coff + np; bool zero = false; float scl = 1.f;
        if (mode == 1) { const int h = np / 192, j = np - h * 192; col = (j < 128) ? np : h * 192 + 128 + ((j - 128) >> 1) + 32 * ((j - 128) & 1); }
        else if (mode == 2) { const int pn = np >> 8, j = np & 255; if (j >= 128) { sp = src2; col = pn * 128 + (j - 128); } else col = pn * 128 + j; }
        else if (mode == 3) { const int g = np >> 7; zero = (kb >> 7) != g; col = (np & 127); sp = src + (size_t)g * 128 * 128 - (size_t)(g * 128) * 128; scl = sn[np]; }
        else if (mode == 4) { zero = np >= DIN; }
        __syncthreads();
#pragma unroll
        for (int i = 0; i < 8; ++i) { const int kl = (tid >> 6) + 8 * i, k = kb + kl;
            float v = 0.f;
            if (!zero) { if (mode == 3) v = src[((size_t)(np >> 7) * 128 + (k & 127)) * 128 + col] * scl; else v = sp[(size_t)k * ldsrc + col] * (gk ? gk[k] : 1.f); }
            tile[kl * 65 + nl] = v; }
        __syncthreads();
        { const int nn = tid >> 3, kc = (tid & 7) * 8; float v[8];
#pragma unroll
          for (int j = 0; j < 8; ++j) v[j] = tile[(kc + j) * 65 + nn];
          u32x4 w; w.x = cvt_pk_bf16(v[0], v[1]); w.y = cvt_pk_bf16(v[2], v[3]); w.z = cvt_pk_bf16(v[4], v[5]); w.w = cvt_pk_bf16(v[6], v[7]);
          *(u32x4*)(dst + (size_t)(nb + nn) * K + kb + kc) = w; }
    }
    __syncthreads();
}

struct CTile { const float* sa; const float* sb; const float* gk; bf16_t* dst; int ld, K, nb, kb, nlim; };
constexpr int CT_MOE = NL * NE * 384, CT_SQ = NL * 4 * 64, CT_UKV = 0, CT_TOTAL = CT_MOE + CT_SQ + CT_UKV;
__device__ __forceinline__ void conv_decode(KP p, unsigned char* ws, int idx, CTile& c) {
    c.nlim = 1 << 30; c.gk = nullptr;
    if (idx < CT_MOE) { const int le = idx / 384, r = idx - le * 384, l = le / NE;
        if (r < 256) { const int nt = r >> 4, kt = r & 15; c.sa = p->w_gate + (size_t)le * DM * DE + nt * 128; c.sb = p->w_up + (size_t)le * DM * DE + nt * 128; c.ld = DE; c.K = 1024; c.gk = p->norm_ffn + l * DM;
            c.dst = (bf16_t*)(ws + OFF_WGU) + (size_t)le * 4096 * 1024; c.nb = nt * 256; c.kb = kt * 64; }
        else { const int r2 = r - 256, nt = r2 >> 5, kt = r2 & 31; c.sa = p->w_down + (size_t)le * DE * DM + nt * 256; c.sb = c.sa + 128; c.ld = DM; c.K = 2048;
            c.dst = (bf16_t*)(ws + OFF_WD) + (size_t)le * 1024 * 2048; c.nb = nt * 256; c.kb = kt * 64; }
    } else if (idx < CT_MOE + CT_SQ) { const int r = idx - CT_MOE, l = r >> 8, q = (r >> 6) & 3, tt = r & 63, nt = tt >> 4, kt = tt & 15; c.K = 1024; c.nb = nt * 256; c.kb = kt * 64; c.ld = DM;
        const float* src; size_t doff;
        if (q == 0) { src = p->w_in + (size_t)l * DM * DIN; c.ld = DIN; c.gk = p->norm_mix + l * DM; c.nlim = DIN; doff = OFF_WIN; }
        else if (q == 1) { src = p->wx_kv + (size_t)l * DM * 2048; c.ld = 2048; doff = OFF_WXK; }
        else if (q == 2) { src = p->wx_kv + (size_t)l * DM * 2048 + 1024; c.ld = 2048; doff = OFF_WXV; }
        else { src = p->wx_o + (size_t)l * DM * DM; doff = OFF_WXO; }
        c.sa = src + nt * 256; c.sb = c.sa + 128; c.dst = (bf16_t*)(ws + doff) + (size_t)l * DM * DM;
    } else { const int r = idx - CT_MOE - CT_SQ, l = r >> 3, tt = r & 7, nt = tt >> 1, kt = tt & 1; c.K = 128; c.nb = nt * 256; c.kb = kt * 64; c.ld = 1024; c.gk = p->kv_norm + l * KVLORA;
        c.sa = p->w_ukv + (size_t)l * KVLORA * 1024 + nt * 256; c.sb = c.sa + 128; c.dst = (bf16_t*)(ws + OFF_WUKV) + (size_t)l * 1024 * 128; }
}
__device__ __forceinline__ void conv_load(const CTile& c, int wid, int lane, f32x4 (&r)[8], float (&g)[8]) {
    const float* base = (lane < 32 ? c.sa : c.sb) + (lane & 31) * 4; const bool ok = (c.nb + lane * 4) < c.nlim;
#pragma unroll
    for (int i = 0; i < 8; ++i) { const int k = c.kb + wid + 8 * i; r[i] = ok ? *(const f32x4*)(base + (size_t)k * c.ld) : (f32x4){0.f, 0.f, 0.f, 0.f}; g[i] = c.gk ? c.gk[k] : 1.f; }
}
#define CONV_BAR() do { asm volatile("s_waitcnt lgkmcnt(0)" ::: "memory"); __builtin_amdgcn_s_barrier(); asm volatile("" ::: "memory"); } while (0)
#define CONV_TILE(C, R, G) do { CONV_BAR(); \
        _Pragma("unroll") for (int i = 0; i < 8; ++i) { const int kl = wid + 8 * i; *(f32x4*)(tile + kl * 260 + ((lane * 4) ^ (((kl >> 3) & 7) << 2))) = R[i] * G[i]; } \
        CONV_BAR(); } while (0)
#define CONV_OUT(C) do { _Pragma("unroll") for (int i = 0; i < 4; ++i) { const int n = nn + 64 * i; float v[8]; \
            _Pragma("unroll") for (int j = 0; j < 8; ++j) v[j] = tile[(8 * kc + j) * 260 + (n ^ (kc << 2))]; \
            u32x4 w; w.x = cvt_pk_bf16(v[0], v[1]); w.y = cvt_pk_bf16(v[2], v[3]); w.z = cvt_pk_bf16(v[4], v[5]); w.w = cvt_pk_bf16(v[6], v[7]); \
            *(u32x4*)(C.dst + (size_t)(C.nb + n) * C.K + C.kb + 8 * kc) = w; } } while (0)
__device__ __forceinline__ void conv_fast(const int wv_, KP p, unsigned char* ws, unsigned char* lds, const int idx0, const int idx1) {
    float* tile = (float*)lds;
    const int tid = TID(), wid = tid >> 6, lane = tid & 63, kc = tid & 7, nn = tid >> 3;
    const int nblk = NBLK(); int idx = idx0 + BID();
    CTile cA, cB; f32x4 rA[8], rB[8]; float gA[8], gB[8];
    if (idx < idx1) { conv_decode(p, ws, idx, cA); conv_load(cA, wid, lane, rA, gA); }
    if (idx + nblk < idx1) { conv_decode(p, ws, idx + nblk, cB); conv_load(cB, wid, lane, rB, gB); }
    for (; idx < idx1; idx += 2 * nblk) {
        { CTile c = cA; CONV_TILE(c, rA, gA);
          if (idx + 2 * nblk < idx1) { conv_decode(p, ws, idx + 2 * nblk, cA); conv_load(cA, wid, lane, rA, gA); }
          CONV_OUT(c); }
        if (idx + nblk < idx1) { CTile c = cB; CONV_TILE(c, rB, gB);
          if (idx + 3 * nblk < idx1) { conv_decode(p, ws, idx + 3 * nblk, cB); conv_load(cB, wid, lane, rB, gB); }
          CONV_OUT(c); }
    }
    __syncthreads();
}
#undef CONV_TILE
#undef CONV_OUT
#undef CONV_BAR

__device__ __forceinline__ void phase_prologue(const int wv_, KP p, unsigned char* lds) {
    unsigned char* ws = lnd_p(p->ws);
    conv_fast(wv_, p, ws, lds, 0, NE * 384);
    conv_fast(wv_, p, ws, lds, CT_MOE, CT_TOTAL);
    { bf16_t* wq = (bf16_t*)(ws + OFF_WXQ);
      for (int i = BID() * NTHREADS + TID(); i < NL * DM * DM / 8; i += NBLK() * NTHREADS) { const int lk = i >> 7; const float g = p->norm_x[lk];
          const f32x4 a = *(const f32x4*)(p->wx_q + (size_t)i * 8), b = *(const f32x4*)(p->wx_q + (size_t)i * 8 + 4); st_bf16x8(wq + (size_t)i * 8, a * g, b * g); } }
    for (int l = 0; l < NL; ++l) {
        conv_job(wv_, lds, p->w_uq + (size_t)l * QLORA * 768, nullptr, 768, 0, (bf16_t*)(ws + OFF_WUQ) + (size_t)l * 768 * 256, 256, 768, p->q_norm + l * QLORA, nullptr, 1);
    }
    const int tid = TID(), wid = tid >> 6, lane = tid & 63, gw = BID() * 8 + wid, nw = NBLK() * 8;
    { bf16_t* xb = (bf16_t*)(ws + OFF_XB); float* rsA = (float*)(ws + OFF_RSA);
      for (int t = gw; t < T; t += nw) { float ss = 0.f;
#pragma unroll
          for (int i = 0; i < 4; ++i) { const f32x4 v = *(const f32x4*)(p->x + (size_t)t * DM + i * 256 + lane * 4); ss += (v[0] * v[0] + v[1] * v[1]) + (v[2] * v[2] + v[3] * v[3]); st_bf16x4(xb + (size_t)t * DM + i * 256 + lane * 4, v); }
          ss = wave_sum(ss); if (lane == 0) rsA[t] = rsqrtf(ss * (1.f / DM) + EPS); } }
    { bf16_t* mb = (bf16_t*)(ws + OFF_MB);
      for (int r = gw; r < NB * NMEM; r += nw) { f32x4 v[4]; float ss = 0.f;
#pragma unroll
          for (int i = 0; i < 4; ++i) { v[i] = *(const f32x4*)(p->mem + (size_t)r * DM + i * 256 + lane * 4); ss += (v[i][0] * v[i][0] + v[i][1] * v[i][1]) + (v[i][2] * v[i][2] + v[i][3] * v[i][3]); }
          ss = wave_sum(ss); const float rs = rsqrtf(ss * (1.f / DM) + EPS);
          for (int l = 0; l < NL; ++l)
#pragma unroll
              for (int i = 0; i < 4; ++i) { const f32x4 g = *(const f32x4*)(p->mem_norm + l * DM + i * 256 + lane * 4); st_bf16x4(mb + ((size_t)l * 2048 + r) * DM + i * 256 + lane * 4, v[i] * rs * g); } } }
    { f32x2* cs = (f32x2*)(ws + OFF_CS);
      for (int i = BID() * NTHREADS + tid; i < T * 32; i += NBLK() * NTHREADS) { const int t = i >> 5, pp = i & 31; const float ang = (float)p->pos[t] * p->inv_freq[pp]; float c, s; sincos_acc(ang, c, s); cs[i] = (f32x2){c, s}; } }
}

__device__ __forceinline__ void phase_weff(const int wv_, KP p, unsigned char* lds) {
    float* tx = (float*)lds;
    float* ty = tx + 128 * 68;
    const int tid = TID(); bf16_t* woutT = (bf16_t*)(lnd_p(p->ws) + OFF_WOUT); bf16_t* wuqT = (bf16_t*)(lnd_p(p->ws) + OFF_WUQ);
    constexpr int N_AB = NL * 8 * 16, N_C = NL * 4 * 2 * 2;
    for (int it = BID(); it < N_AB + N_C; it += NBLK()) {
        __syncthreads();
        bf16_t* dst; int ld;
        if (it < N_AB) { const int l = it >> 7, g = (it >> 4) & 7, n0 = (it & 15) * 64;
            if (g < 4) {
                for (int i = tid; i < 128 * 64; i += NTHREADS) { const int d = i >> 6, rr = i & 63; tx[d * 68 + rr] = p->w_out[((size_t)l * DM + g * 128 + d) * DM + n0 + rr] * p->pool_scale[l * DPOOL + g * 128 + d]; }
                for (int i = tid; i < 128 * 128; i += NTHREADS) { const int c = i >> 7, d = i & 127; ty[d * 132 + c] = p->w_pool[(((size_t)l * 4 + g) * 128 + c) * 128 + d]; }
            } else { const int h = g - 4;
                for (int i = tid; i < 128 * 64; i += NTHREADS) { const int d = i >> 6, rr = i & 63; tx[d * 68 + rr] = p->w_out[((size_t)l * DM + 512 + h * 128 + d) * DM + n0 + rr]; }
                for (int i = tid; i < 128 * 128; i += NTHREADS) { const int c = i >> 7, d = i & 127; ty[d * 132 + c] = p->w_ukv[((size_t)l * KVLORA + c) * 1024 + h * 256 + 128 + d] * p->kv_norm[l * KVLORA + c]; }
            }
            dst = woutT + ((size_t)l * DM + n0) * DM + g * 128; ld = DM;
        } else { const int q = it - N_AB, l = q >> 4, h = (q >> 2) & 3, jt = (q >> 1) & 1, kc = q & 1;
            for (int i = tid; i < 128 * 64; i += NTHREADS) { const int d = i & 127, rr = i >> 7, j = jt * 64 + rr; tx[d * 68 + rr] = p->w_ukv[((size_t)l * KVLORA + j) * 1024 + h * 256 + d] * p->kv_norm[l * KVLORA + j]; }
            for (int i = tid; i < 128 * 128; i += NTHREADS) { const int d = i & 127, c = i >> 7, k = kc * 128 + c; ty[d * 132 + c] = p->w_uq[((size_t)l * QLORA + k) * 768 + h * 192 + d] * p->q_norm[l * QLORA + k]; }
            dst = wuqT + ((size_t)l * 768 + h * 192 + jt * 64) * 256 + kc * 128; ld = 256;
        }
        __syncthreads();
        const int r0 = (tid >> 5) * 4, c0 = (tid & 31) * 4; f32x4 acc[4];
#pragma unroll
        for (int j = 0; j < 4; ++j) acc[j] = (f32x4){0.f, 0.f, 0.f, 0.f};
#pragma unroll 4
        for (int d = 0; d < 128; ++d) { const f32x4 xv = *(const f32x4*)(tx + d * 68 + r0), yv = *(const f32x4*)(ty + d * 132 + c0);
            acc[0] += xv[0] * yv; acc[1] += xv[1] * yv; acc[2] += xv[2] * yv; acc[3] += xv[3] * yv; }
#pragma unroll
        for (int j = 0; j < 4; ++j) st_bf16x4(dst + (size_t)(r0 + j) * ld + c0, acc[j]);
    }
    __syncthreads();
}

__device__ __forceinline__ void phase_mix_thin(const int wv_, KP p) {
    unsigned char* ws = lnd_p(p->ws);
    const bf16_t* proj = (const bf16_t*)(ws + OFF_PROJ); bf16_t* dP = (bf16_t*)(ws + OFF_CAT); float* rsq = (float*)(ws + OFF_RSQ); float* rskv = (float*)(ws + OFF_RSKV);
    bf16_t* Kf = (bf16_t*)(ws + OFF_KF); const f32x2* cs = (const f32x2*)(ws + OFF_CS);
    const int tid = TID(), wid = tid >> 6, lane = tid & 63;
    const int g = lane >> 4, w = 2 << g, left = w >> 1, right = w - 1 - left;
    for (int t0 = (BID() * 8 + wid) * 4; t0 < T; t0 += NBLK() * 32) {
        const int b = t0 >> 12, s0 = t0 & 4095;
        u32x4 nb[19];
#pragma unroll
        for (int r = 0; r < 19; ++r) { const int sr = min(max(s0 + r - 8, 0), SEQ - 1); nb[r] = *(const u32x4*)(proj + ((size_t)b * SEQ + sr) * 1024 + lane * 8); }
        u32x2 wq[4]; unsigned wkv[4]; float kr[4]; f32x2 cc[4];
#pragma unroll
        for (int i = 0; i < 4; ++i) { const bf16_t* row = proj + (size_t)(t0 + i) * 1024; wq[i] = *(const u32x2*)(row + 512 + lane * 4); wkv[i] = *(const unsigned*)(row + 768 + lane * 2); kr[i] = bf2f(row[896 + lane]);
            cc[i] = cs[(size_t)(t0 + i) * 32 + (lane & 31)]; }
#pragma unroll
        for (int i = 0; i < 4; ++i) { const int t = t0 + i, s = s0 + i;
            { const float a0 = bflo(wq[i].x), a1 = bfhi(wq[i].x), a2 = bflo(wq[i].y), a3 = bfhi(wq[i].y);
              const float ss = wave_sum((a0 * a0 + a1 * a1) + (a2 * a2 + a3 * a3)); if (lane == 0) rsq[t] = rsqrtf(ss * (1.f / QLORA) + EPS); }
            { const float a0 = bflo(wkv[i]), a1 = bfhi(wkv[i]);
              const float ss = wave_sum(a0 * a0 + a1 * a1); const float rk = rsqrtf(ss * (1.f / KVLORA) + EPS);
              *(unsigned*)(Kf + ((size_t)b * SEQ + s) * DQK + lane * 2) = cvt_pk_bf16(a0 * rk, a1 * rk); }
            { const float mine = kr[i], other = shx<32>(mine); const int pp = lane & 31; const f32x2 c = cc[i];
              const float t1 = lane < 32 ? mine : other, t2 = lane < 32 ? other : mine; const float o = lane < 32 ? t1 * c.x - t2 * c.y : t1 * c.y + t2 * c.x;
              const bf16_t ob = (bf16_t)(cvt_pk_bf16(o, 0.f) & 0xffffu); const int jj = 128 + 2 * pp + (lane >> 5);
              Kf[((size_t)b * SEQ + s) * DQK + jj] = ob; }
            { const int lo = max(s - left, 0), hi = min(s + right + 1, SEQ); float sum[8];
#pragma unroll
              for (int q = 0; q < 8; ++q) sum[q] = 0.f;
#pragma unroll
              for (int j = 0; j < 16; ++j) { const int sj = s + j - 8; const float m = (sj >= lo && sj < hi) ? 1.f : 0.f; const u32x4 v = nb[i + j];
                  sum[0] += m * bflo(v.x); sum[1] += m * bfhi(v.x); sum[2] += m * bflo(v.y); sum[3] += m * bfhi(v.y); sum[4] += m * bflo(v.z); sum[5] += m * bfhi(v.z); sum[6] += m * bflo(v.w); sum[7] += m * bfhi(v.w); }
              const u32x4 c4 = nb[i + 8]; const float inv = 1.f / (float)(hi - lo);
              u32x4 o; o.x = cvt_pk_bf16(sum[0] * inv - bflo(c4.x), sum[1] * inv - bfhi(c4.x)); o.y = cvt_pk_bf16(sum[2] * inv - bflo(c4.y), sum[3] * inv - bfhi(c4.y));
              o.z = cvt_pk_bf16(sum[4] * inv - bflo(c4.z), sum[5] * inv - bfhi(c4.z)); o.w = cvt_pk_bf16(sum[6] * inv - bflo(c4.w), sum[7] * inv - bfhi(c4.w));
              *(u32x4*)(dP + (size_t)t * 1024 + lane * 8) = o; }
            __builtin_amdgcn_sched_barrier(0);
        }
    }
}

#ifndef PROBE_VAR
#define PROBE_VAR 0
#endif
__device__ __forceinline__ void phase_attn(const int wv_, KP p, unsigned char* lds, int dry) {
    unsigned char* ws = lnd_p(p->ws);
    const bf16_t* Qf = (const bf16_t*)(ws + OFF_QF); const bf16_t* Kf = (const bf16_t*)(ws + OFF_KF); bf16_t* cat = (bf16_t*)(ws + OFF_CAT);
    const int G = NBLK();
    for (int i = BID(); i < NB * NH * 16; i += G) {
        int u = i;
        if (G == 256) { const int rnd = i >> 8, bid = i & 255, xcd = bid & 7, j = bid >> 3; u = (((rnd * 8 + xcd) * 2 + (j >> 4)) << 4) + (j & 15); }
        const int bh = u >> 4, qb = u & 15, b = bh >> 2, h = bh & 3;
        if (!dry) att::attn_dense_body<0>(wv_, Qf + ((size_t)bh * SEQ + qb * 256) * DQK, Kf + (size_t)b * SEQ * DQK, Kf + (size_t)b * SEQ * DQK,
                             cat + ((size_t)b * SEQ + qb * 256) * 1024 + 512 + h * 128, SEQ, lds);
        else att::attn_dense_body<PROBE_VAR>(wv_, Qf + ((size_t)bh * SEQ + qb * 256) * DQK, Kf + (size_t)b * SEQ * DQK, Kf + (size_t)b * SEQ * DQK,
                             (bf16_t*)(lnd_p(p->ws) + OFF_QX) + ((size_t)b * SEQ + qb * 256) * 1024 + 512 + h * 128, SEQ, lds);
    }
}

__device__ __forceinline__ float bf_el(const u32x4& v, int e) { const unsigned w = (e >> 1) == 0 ? v.x : (e >> 1) == 1 ? v.y : (e >> 1) == 2 ? v.z : v.w; return (e & 1) ? bfhi(w) : bflo(w); }
__device__ __forceinline__ void phase_router(const int wv_, KP p, int l, unsigned char* lds) {
    float* W = (float*)lds;
    const int tid = TID(), wid = tid >> 6, lane = tid & 63, r = lane & 15, kq = lane >> 4;
    const float* wr = p->w_router + (size_t)l * DM * NE; const float* g = p->norm_ffn + l * DM;
    __syncthreads();
    for (int idx = tid; idx < DM * NE; idx += NTHREADS) { const int k = idx >> 4, e = idx & 15; W[k * 18 + e] = wr[idx] * g[k]; }
    __syncthreads();
    const bf16_t* x = (const bf16_t*)(lnd_p(p->ws) + OFF_XB); float* aff = (float*)(lnd_p(p->ws) + OFF_AFF); float* rsC = (float*)(lnd_p(p->ws) + OFF_RSC);
    const float* wl = W + (8 * kq) * 18 + r;
    for (int t0 = (BID() * 8 + wid) * 16; t0 < T; t0 += NBLK() * 128) {
        const bf16_t* xr = x + (size_t)(t0 + r) * DM + 8 * kq;
        f32x4 acc0 = {0.f, 0.f, 0.f, 0.f}, acc1 = {0.f, 0.f, 0.f, 0.f}; float ss = 0.f;
        u32x4 xc[8];
#pragma unroll
        for (int i = 0; i < 8; ++i) xc[i] = *(const u32x4*)(xr + 32 * i);
#pragma unroll
        for (int jc = 0; jc < 4; ++jc) {
            u32x4 xn[8];
            if (jc < 3) {
#pragma unroll
                for (int i = 0; i < 8; ++i) xn[i] = *(const u32x4*)(xr + 32 * (8 * (jc + 1) + i)); }
#pragma unroll
            for (int i = 0; i < 8; ++i) { const float* wj = wl + (32 * (8 * jc + i)) * 18;
#pragma unroll
                for (int e = 0; e < 8; e += 2) { const float a0 = bf_el(xc[i], e), a1 = bf_el(xc[i], e + 1); ss += a0 * a0 + a1 * a1;
                    acc0 = __builtin_amdgcn_mfma_f32_16x16x4f32(a0, wj[e * 18], acc0, 0, 0, 0);
                    acc1 = __builtin_amdgcn_mfma_f32_16x16x4f32(a1, wj[(e + 1) * 18], acc1, 0, 0, 0); } }
            if (jc < 3) {
#pragma unroll
                for (int i = 0; i < 8; ++i) xc[i] = xn[i]; }
        }
        ss += shx<16>(ss); ss = shx_sum32(ss);
        const float rs = rsqrtf(ss * (1.f / DM) + EPS);
        if (kq == 0) rsC[t0 + r] = rs;
        const int b = t0 >> 12, sq = t0 & 4095; f32x4 pr;
#pragma unroll
        for (int q = 0; q < 4; ++q) { const float rq = __uint_as_float((unsigned)__builtin_amdgcn_ds_bpermute((4 * kq + q) << 2, (int)__float_as_uint(rs)));
            const float v = (acc0[q] + acc1[q]) * rq;
            float m = fmaxf(v, shx<8>(v)); m = fmaxf(m, shx<4>(m)); m = fmaxf(m, shx<2>(m)); m = fmaxf(m, shx<1>(m));
            const float e = __expf(v - m); float z = e + shx<8>(e); z += shx<4>(z); z += shx<2>(z); z += shx<1>(z);
            pr[q] = e / z; }
        *(f32x4*)(aff + ((size_t)(b * NE + r)) * SEQ + sq + 4 * kq) = pr;
    }
    __syncthreads();
}

__device__ __forceinline__ void phase_select(const int wv_, KP p, unsigned char* lds) {
    unsigned* hist = (unsigned*)lds; unsigned* wtot = hist + 256; unsigned* bc = wtot + 16; int* sel = (int*)(bc + 16);
    unsigned char* ws = lnd_p(p->ws);
    const float* aff = (const float*)(ws + OFF_AFF); int* slot = (int*)(ws + OFF_SLOT); float* gate = (float*)(ws + OFF_GATE); float* rsrow = (float*)(ws + OFF_RSROW);
    const float* rsC = (const float*)(ws + OFF_RSC); const bf16_t* xb = (const bf16_t*)(ws + OFF_XB); bf16_t* xt = (bf16_t*)(ws + OFF_XT);
    const int tid = TID(), wid = tid >> 6, lane = tid & 63;
    int* tok = (int*)(ws + OFF_XT);
    for (int item = BID(); item < NB * NE; item += NBLK()) {
        const int par = 0; const int b = item >> 4, e = item & 15;
        const float* a = aff + (size_t)item * SEQ + tid * 8;
        const f32x4 v0 = *(const f32x4*)a, v1 = *(const f32x4*)(a + 4);
        float v[8] = {v0[0], v0[1], v0[2], v0[3], v1[0], v1[1], v1[2], v1[3]}; unsigned bits[8];
#pragma unroll
        for (int i = 0; i < 8; ++i) bits[i] = __float_as_uint(v[i]);
        unsigned prefix = 0;
        for (int bit = 30; bit >= 0; --bit) {
            const unsigned cand = prefix | (1u << bit); unsigned wc_ = 0;
#pragma unroll
            for (int i = 0; i < 8; ++i) wc_ += (unsigned)__popcll(__ballot(bits[i] >= cand));
            unsigned* slotw = wtot + ((bit & 1) << 3);
            if (lane == 0) slotw[wid] = wc_;
            __syncthreads();
            unsigned tot = 0;
#pragma unroll
            for (int w = 0; w < 8; ++w) tot += slotw[w];
            if (tot >= (unsigned)CAP) prefix = cand;
        }
        unsigned cgt = 0;
#pragma unroll
        for (int i = 0; i < 8; ++i) cgt += (unsigned)__popcll(__ballot(bits[i] > prefix));
        __syncthreads();
        if (lane == 0) bc[wid] = cgt;
        __syncthreads();
        unsigned remaining = CAP;
#pragma unroll
        for (int w = 0; w < 8; ++w) remaining -= bc[w];
        const unsigned thr = prefix, need = remaining;
        unsigned cg = 0, ce = 0;
#pragma unroll
        for (int i = 0; i < 8; ++i) { cg += bits[i] > thr ? 1u : 0u; ce += bits[i] == thr ? 1u : 0u; }
        unsigned pk = cg | (ce << 16), incl = pk;
#pragma unroll
        for (int o = 1; o < 64; o <<= 1) { const unsigned y = (unsigned)__builtin_amdgcn_ds_bpermute((lane - o) << 2, (int)incl); if (lane >= o) incl += y; }
        __syncthreads();
        if (lane == 63) wtot[wid] = incl;
        __syncthreads();
        unsigned base = 0;
#pragma unroll
        for (int w = 0; w < 8; ++w) base += (w < wid) ? wtot[w] : 0u;
        const unsigned ex = base + incl - pk; unsigned gb = ex & 0xffffu, eb = ex >> 16;
#pragma unroll
        for (int i = 0; i < 8; ++i) { const int s = tid * 8 + i; int pos = -1;
            if (bits[i] > thr) { pos = (int)(gb + (eb < need ? eb : need)); ++gb; }
            else if (bits[i] == thr) { if (eb < need) pos = (int)(gb + eb); ++eb; }
            if (par == 0) slot[((size_t)b * SEQ + s) * NE + e] = pos;
            if (pos >= 0) { tok[(size_t)item * CAP + pos] = s; gate[(size_t)item * CAP + pos] = v[i]; rsrow[(size_t)item * CAP + pos] = rsC[b * SEQ + s]; } }
        __syncthreads();
    }
}

__device__ __forceinline__ void acc8(f32x4 (&v)[2], const u32x4& w, float wt) {
    v[0][0] += wt * bflo(w.x); v[0][1] += wt * bfhi(w.x); v[0][2] += wt * bflo(w.y); v[0][3] += wt * bfhi(w.y); v[1][0] += wt * bflo(w.z); v[1][1] += wt * bfhi(w.z); v[1][2] += wt * bflo(w.w); v[1][3] += wt * bfhi(w.w); }
__device__ __forceinline__ void phase_combine(const int wv_, KP p, int last, int dry) {
    unsigned char* ws = lnd_p(p->ws);
    const int* slot = (const int*)(ws + OFF_SLOT); const bf16_t* Y = (const bf16_t*)(ws + OFF_Y); const bf16_t* xin = (const bf16_t*)(ws + OFF_XB); bf16_t* xb = (bf16_t*)(ws + (dry ? OFF_P : OFF_XB)); float* rsA = (float*)(ws + (dry ? OFF_RSQ : OFF_RSA));
    float* xo = dry ? (float*)(ws + OFF_SX) : p->out;
    const int tid = TID(), wid = tid >> 6, lane = tid & 63;
    const int step = NBLK() * 8; int t = BID() * 8 + wid;
    int myslot = (t < T && lane < NE) ? slot[(size_t)t * NE + lane] : -1;
    for (; t < T; t += step) {
        const int b = t >> 12; const int tn = t + step;
        const int nslot = (tn < T && lane < NE) ? slot[(size_t)tn * NE + lane] : -1;
        unsigned long long mask = __ballot(myslot >= 0);
        u32x4 xw[2];
#pragma unroll
        for (int i = 0; i < 2; ++i) xw[i] = *(const u32x4*)(xin + (size_t)t * DM + i * 512 + lane * 8);
        u32x4 yw[4][2]; float wt[4];
#pragma unroll
        for (int j = 0; j < 4; ++j) { int e = 0, c = 0; wt[j] = 0.f;
            if (mask) { e = __builtin_ctzll(mask); mask &= mask - 1; c = __builtin_amdgcn_readlane(myslot, e); wt[j] = 1.f; }
            const bf16_t* yr = Y + ((size_t)(b * NE + e) * CAP + c) * DM;
#pragma unroll
            for (int i = 0; i < 2; ++i) yw[j][i] = *(const u32x4*)(yr + i * 512 + lane * 8); }
        f32x4 v[2][2];
#pragma unroll
        for (int i = 0; i < 2; ++i) { v[i][0] = (f32x4){0.f, 0.f, 0.f, 0.f}; v[i][1] = (f32x4){0.f, 0.f, 0.f, 0.f}; acc8(v[i], xw[i], 1.f); }
#pragma unroll
        for (int j = 0; j < 4; ++j)
#pragma unroll
            for (int i = 0; i < 2; ++i) acc8(v[i], yw[j][i], wt[j]);
        while (mask) { const int e = __builtin_ctzll(mask); mask &= mask - 1; const int c = __builtin_amdgcn_readlane(myslot, e); const bf16_t* yr = Y + ((size_t)(b * NE + e) * CAP + c) * DM;
#pragma unroll
            for (int i = 0; i < 2; ++i) { const u32x4 w2 = *(const u32x4*)(yr + i * 512 + lane * 8); acc8(v[i], w2, 1.f); } }
        float ss = 0.f;
#pragma unroll
        for (int i = 0; i < 2; ++i)
#pragma unroll
            for (int h = 0; h < 2; ++h) ss += (v[i][h][0] * v[i][h][0] + v[i][h][1] * v[i][h][1]) + (v[i][h][2] * v[i][h][2] + v[i][h][3] * v[i][h][3]);
        ss = wave_sum(ss); const float rs = rsqrtf(ss * (1.f / DM) + EPS);
        if (last) {
#pragma unroll
            for (int i = 0; i < 2; ++i)
#pragma unroll
                for (int h = 0; h < 2; ++h) { const int col = i * 512 + lane * 8 + h * 4; const f32x4 g = *(const f32x4*)(p->norm_final + col); *(f32x4*)(xo + (size_t)t * DM + col) = v[i][h] * rs * g; }
        } else {
#pragma unroll
            for (int i = 0; i < 2; ++i) st_bf16x8(xb + (size_t)t * DM + i * 512 + lane * 8, v[i][0], v[i][1]);
            if (lane == 0) rsA[t] = rs;
        }
        myslot = nslot;
    }
}

struct EpiDown {
    bf16_t* Y; const float* gate; static constexpr bool STAGED = true;
    __device__ __forceinline__ float rowscale(const GU& u, int r) const { return gate[u.pm * 256 + r]; }
    __device__ __forceinline__ void operator()(ACC_T, const GU& u, int wr, int wc, int fr, int fq, const LAS float* sc) const {
#pragma unroll
        for (int ai = 0; ai < 2; ++ai)
#pragma unroll
            for (int m = 0; m < 4; ++m) { const int row = ROW_OF; const float s = sc[RLOC_OF];
#pragma unroll
                for (int bj = 0; bj < 2; ++bj) st_bf16x8(Y + (size_t)row * DM + COL8_OF, acc[ai][bj][m][0] * s, acc[ai][bj][m][1] * s); }
    }
};

constexpr int PH_PER_LAYER = 15, PH_TOTAL = 3 + NL * PH_PER_LAYER;

__global__ void __launch_bounds__(NTHREADS, 2) mk_fwd(Params pk) {
    extern __shared__ __attribute__((aligned(16))) unsigned char lds[];
    const int wv_ = __builtin_amdgcn_readfirstlane((int)threadIdx.x >> 6);
    KP p = kargs(); unsigned char* ws = lnd_p(p->ws);
    const int tid = TID();
    volatile LAS unsigned* bst = (volatile LAS unsigned*)(LAS unsigned char*)(lds + LDS_BYTES - 16);
    if (tid == 0) { bst[0] = 0u; bst[1] = 0u; }
    __syncthreads();
    const int lo = pk.ph_lo, hi = pk.ph_hi;
    const bool fused = (hi - lo) > 1;
    XcdBarrier bar; bar.bar = (unsigned*)(ws + OFF_BAR); bar.x = 0; bar.st = bst;
    if (fused) bar = xcd_barrier_post((unsigned*)(ws + OFF_BAR), bst, tid == 0);
#ifdef ONLY_J
#define ON(j) ((j) == ONLY_J)
#else
#define ON(j) true
#endif
#ifndef PROBE_J
#define PROBE_J (-1)
#endif
#ifndef PROBE_N
#define PROBE_N 1
#endif
#define REPS(j) ((j) == PROBE_J ? PROBE_N + 1 : 1)
#define IN(k) (lo <= (k) && (k) < hi)
#define SEAM(k) do { if (IN(k) && IN((k) + 1)) xcd_barrier(bar, TID() == 0); } while (0)

    if (ON(100) && IN(0)) for (int rep = 0; rep < REPS(100); ++rep) { phase_prologue(wv_, kargs(), lds); phase_weff(wv_, kargs(), lds); SEAM(0); }
    if (ON(101) && IN(1)) for (int rep = 0; rep < REPS(101); ++rep) { KP p = kargs(); unsigned char* ws = lnd_p(p->ws);
        static_assert(OFF_VXT == OFF_KX + (size_t)NL * 2048 * 1024 * 2, "vx must follow kx");
        { DescKV d{(const bf16_t*)(ws + OFF_MB), (const bf16_t*)(ws + OFF_WXK), (const bf16_t*)(ws + OFF_WXV), 1024, 1024, 1024, 256}; EpiBf16 E{(bf16_t*)(ws + OFF_KX), 1024, nullptr, 1.f}; GEMM(lds, d, E); }
        SEAM(1);
    }
    for (int l = 0; l < NL; ++l) {
        const int P0 = 3 + l * PH_PER_LAYER;
        if (ON(0) && IN(P0 + 0)) for (int rep = 0; rep < REPS(0); ++rep) { KP p = kargs(); unsigned char* ws = lnd_p(p->ws); bf16_t* xb = (bf16_t*)(ws + OFF_XB);
            DescPlain d{xb, (const bf16_t*)(ws + OFF_WIN) + (size_t)l * 1024 * 1024, 1024, 1024, 1024, T / 256, 4, (T / 256) * 4};
            EpiBf16 E{(bf16_t*)(ws + OFF_PROJ), 1024, (const float*)(ws + OFF_RSA), 1.f}; GEMM(lds, d, E); SEAM(P0 + 0);
        }
        if (ON(1) && IN(P0 + 1)) for (int rep = 0; rep < REPS(1); ++rep) { phase_mix_thin(wv_, kargs()); SEAM(P0 + 1); }
        if (ON(2) && IN(P0 + 2)) for (int rep = 0; rep < REPS(2); ++rep) { KP p = kargs(); unsigned char* ws = lnd_p(p->ws); bf16_t* xb = (bf16_t*)(ws + OFF_XB);
            { DescPlain d{(const bf16_t*)(ws + OFF_PROJ) + 512, (const bf16_t*)(ws + OFF_WUQ) + (size_t)l * 768 * 256, 1024, 256, 256, T / 256, 3, (T / 256) * 3};
              EpiQ E{(bf16_t*)(ws + OFF_QF), (const float*)(ws + OFF_RSQ), (const f32x2*)(ws + OFF_CS)}; GEMM(lds, d, E); }
            { DescMt d{(const bf16_t*)(ws + OFF_KX), (const bf16_t*)(ws + OFF_WXQ), 1024, 1024, 256, 128, l * 128, 128}; EpiBf16 E{(bf16_t*)(ws + OFF_MT), 1024, nullptr, 1.f}; GEMM(lds, d, E); }
            if (l == 0) { DescNt d{(const bf16_t*)(ws + OFF_WXO), (const bf16_t*)(ws + OFF_VXT), 1024, 1024, 256, 128, 0, 0}; EpiBf16 E{(bf16_t*)(ws + OFF_NT), 1024, nullptr, 1.f}; GEMM(lds, d, E); }
            SEAM(P0 + 2);
        }
        if (ON(3) && IN(P0 + 3)) for (int rep = 0; rep < REPS(3); ++rep) { phase_attn(wv_, kargs(), lds, rep); SEAM(P0 + 3); }
        if (ON(4) && IN(P0 + 4)) for (int rep = 0; rep < REPS(4); ++rep) { KP p = kargs(); unsigned char* ws = lnd_p(p->ws); bf16_t* xb = (bf16_t*)(ws + OFF_XB);
            DescPlain d{(const bf16_t*)(ws + OFF_CAT), (const bf16_t*)(ws + OFF_WOUT) + (size_t)l * DM * DM, 1024, 1024, 1024, T / 256, 4, (T / 256) * 4};
            EpiResid E{xb, rep ? (bf16_t*)(ws + OFF_P) : xb, rep ? nullptr : (float*)(ws + OFF_SSPB)}; GEMM(lds, d, E); SEAM(P0 + 4);
        }
        if (ON(5) && IN(P0 + 5)) for (int rep = 0; rep < REPS(5); ++rep) { KP p = kargs(); unsigned char* ws = lnd_p(p->ws); bf16_t* xb = (bf16_t*)(ws + OFF_XB);
            DescXB d{xb, (const bf16_t*)(ws + OFF_MT) + (size_t)l * NB * 4 * 256 * 1024, 1024, 1024, 1024, (T / 256) * 4};
            EpiSoftmax E{(bf16_t*)(ws + OFF_P), (LAS float*)((LAS unsigned char*)lds + 147456), (const float*)(ws + OFF_SSPB), 0.0625f}; GEMM(lds, d, E); SEAM(P0 + 5);
        }
        if (ON(9) && IN(P0 + 9)) for (int rep = 0; rep < REPS(9); ++rep) { KP p = kargs(); unsigned char* ws = lnd_p(p->ws); bf16_t* xb = (bf16_t*)(ws + OFF_XB);
            DescXB d{(const bf16_t*)(ws + OFF_P), (const bf16_t*)(ws + OFF_NT) + (size_t)l * NB * 1024 * 1024, 1024, 1024, 1024, (T / 256) * 4};
            EpiResid E{xb, rep ? (bf16_t*)(ws + OFF_QX) : xb, nullptr}; GEMM(lds, d, E); SEAM(P0 + 9);
        }
        if (ON(10) && IN(P0 + 10)) for (int rep = 0; rep < REPS(10); ++rep) { phase_router(wv_, kargs(), l, lds); SEAM(P0 + 10); }
        if (ON(11) && IN(P0 + 11)) for (int rep = 0; rep < REPS(11); ++rep) { phase_select(wv_, kargs(), lds);
            if (l + 1 < NL) { KP p = kargs(); unsigned char* ws = lnd_p(p->ws);
                DescNt d{(const bf16_t*)(ws + OFF_WXO), (const bf16_t*)(ws + OFF_VXT), 1024, 1024, 256, 128, (l + 1) * 128, 128}; EpiBf16 E{(bf16_t*)(ws + OFF_NT), 1024, nullptr, 1.f}; GEMM(lds, d, E); }
            SEAM(P0 + 11); }
        if (ON(12) && IN(P0 + 12)) for (int rep = 0; rep < REPS(12); ++rep) { KP p = kargs(); unsigned char* ws = lnd_p(p->ws); bf16_t* xb = (bf16_t*)(ws + OFF_XB);
            const int r0 = (l + 1 < NL) ? 2 * (BID() & 7) : 16;
            EpiSwiglu E{(bf16_t*)(ws + OFF_ACT), (const float*)(ws + OFF_RSROW)};
            if (r0 > 0) { DescGU d{xb, (const int*)(ws + OFF_XT), (const bf16_t*)(ws + OFF_WGU) + (size_t)l * NE * 4096 * 1024, 1024, 1024, 1024, r0 * 256, 0}; GEMM(lds, d, E); }
            if (l + 1 < NL) conv_fast(wv_, p, ws, lds, (l + 1) * NE * 384, (l + 2) * NE * 384);
            if (r0 < 16) { DescGU d{xb, (const int*)(ws + OFF_XT), (const bf16_t*)(ws + OFF_WGU) + (size_t)l * NE * 4096 * 1024, 1024, 1024, 1024, (16 - r0) * 256, r0 * 256}; GEMM(lds, d, E); }
            SEAM(P0 + 12);
        }
        if (ON(13) && IN(P0 + 13)) for (int rep = 0; rep < REPS(13); ++rep) { KP p = kargs(); unsigned char* ws = lnd_p(p->ws); bf16_t* xb = (bf16_t*)(ws + OFF_XB);
            DescDown d{(const bf16_t*)(ws + OFF_ACT), (const bf16_t*)(ws + OFF_WD) + (size_t)l * NE * 1024 * 2048, 2048, 2048, 2048, NE * 64};
            EpiDown E{(bf16_t*)(ws + OFF_Y), (const float*)(ws + OFF_GATE)}; GEMM(lds, d, E); SEAM(P0 + 13);
        }
        if (ON(14) && IN(P0 + 14)) for (int rep = 0; rep < REPS(14); ++rep) { phase_combine(wv_, kargs(), l == NL - 1, rep); SEAM(P0 + 14); }
    }
#undef IN
#undef SEAM
}

#ifndef MK_FUSED
#define MK_FUSED 1
#endif
extern "C" void kernel_launch(void* const* d_in, const int* in_sizes, int n_in, void* d_out, int out_size, void* d_ws, size_t ws_size, hipStream_t stream) {
    static int grid = 0;
    if (grid == 0) {
        if (n_in != 23 || in_sizes[0] != T * DM || out_size != T * DM || ws_size < WS_NEED) {
            fprintf(stderr, "kernel_launch: unexpected shapes: n_in %d in0 %d out %d ws %zu (need %zu)\n", n_in, n_in > 0 ? in_sizes[0] : -1, out_size, ws_size, (size_t)WS_NEED); grid = -1; return; }
        int dev = 0, cus = 0, per_cu = 0;
        if (hipGetDevice(&dev) != hipSuccess || hipDeviceGetAttribute(&cus, hipDeviceAttributeMultiprocessorCount, dev) != hipSuccess) { grid = -1; return; }
        if (hipFuncSetAttribute((const void*)mk_fwd, hipFuncAttributeMaxDynamicSharedMemorySize, LDS_BYTES) != hipSuccess) { fprintf(stderr, "kernel_launch: hipFuncSetAttribute failed\n"); grid = -1; return; }
        if (hipOccupancyMaxActiveBlocksPerMultiprocessor(&per_cu, (const void*)mk_fwd, NTHREADS, LDS_BYTES) != hipSuccess || per_cu < 1) fprintf(stderr, "kernel_launch: occupancy query says %d\n", per_cu);
        (void)hipGetLastError();
        grid = cus;
    }
    if (grid < 0) return;
    (void)hipMemsetAsync((char*)d_ws + OFF_BAR, 0, XCD_BAR_WORDS * sizeof(unsigned), stream);
    Params p{};
    p.x = (const float*)d_in[0]; p.mem = (const float*)d_in[1]; p.pos = (const int*)d_in[2]; p.norm_mix = (const float*)d_in[3]; p.w_in = (const float*)d_in[4];
    p.q_norm = (const float*)d_in[5]; p.kv_norm = (const float*)d_in[6]; p.w_uq = (const float*)d_in[7]; p.w_ukv = (const float*)d_in[8]; p.w_pool = (const float*)d_in[9];
    p.pool_scale = (const float*)d_in[10]; p.w_out = (const float*)d_in[11]; p.norm_x = (const float*)d_in[12]; p.mem_norm = (const float*)d_in[13]; p.wx_q = (const float*)d_in[14];
    p.wx_kv = (const float*)d_in[15]; p.wx_o = (const float*)d_in[16]; p.norm_ffn = (const float*)d_in[17]; p.w_router = (const float*)d_in[18]; p.w_gate = (const float*)d_in[19];
    p.w_up = (const float*)d_in[20]; p.w_down = (const float*)d_in[21]; p.norm_final = (const float*)d_in[22];
    p.out = (float*)d_out; p.ws = (unsigned char*)d_ws;
    for (int i = 0; i < 32; ++i) p.inv_freq[i] = (float)pow(10000.0, -(double)i / 32.0);
#if MK_FUSED
    p.ph_lo = 0; p.ph_hi = PH_TOTAL;
    hipLaunchKernelGGL(mk_fwd, dim3(grid), dim3(NTHREADS), LDS_BYTES, stream, p);
#else
    for (int ph = 0; ph < PH_TOTAL; ++ph) { p.ph_lo = ph; p.ph_hi = ph + 1; hipLaunchKernelGGL(mk_fwd, dim3(grid), dim3(NTHREADS), LDS_BYTES, stream, p); }
#endif
    const hipError_t le = hipPeekAtLastError();
    if (le != hipSuccess) fprintf(stderr, "kernel_launch: launch failed: %s\n", hipGetErrorName(le));
}
```

```cpp
#include <hip/hip_runtime.h>
#include <stdint.h>
#include <stdio.h>
#include <math.h>

constexpr int NB = 8, SEQ = 4096, T = NB * SEQ, DM = 1024, NL = 4;
constexpr int DPOOL = 512, QLORA = 256, KVLORA = 128, QKROPE = 64, DIN = 960;
constexpr int NH = 4, DQK = 192, DV = 128;
constexpr int NMEM = 256, NXH = 4, XHD = 256;
constexpr int NE = 16, CAP = 512, DE = 2048, NROWS = NB * NE * CAP;
constexpr float EPS = 1e-6f;

typedef unsigned short bf16_t;
typedef short bf16x8 __attribute__((ext_vector_type(8)));
typedef float f32x4 __attribute__((ext_vector_type(4)));
typedef float f32x2 __attribute__((ext_vector_type(2)));
typedef float f32x16 __attribute__((ext_vector_type(16)));
typedef short s16x4 __attribute__((ext_vector_type(4)));
typedef unsigned u32x4 __attribute__((ext_vector_type(4)));
typedef unsigned u32x2 __attribute__((ext_vector_type(2)));

constexpr size_t MiB = 1ull << 20;
constexpr size_t OFF_BAR = 0;
constexpr size_t OFF_WIN = 1 * MiB;
constexpr size_t OFF_WUQ = OFF_WIN + 8 * MiB;
constexpr size_t OFF_WUKV = OFF_WUQ + 2 * MiB;
constexpr size_t OFF_WPOOL = OFF_WUKV + 1 * MiB;
constexpr size_t OFF_WOUT = OFF_WPOOL + 2 * MiB;
constexpr size_t OFF_WXQ = OFF_WOUT + 8 * MiB;
constexpr size_t OFF_WXK = OFF_WXQ + 8 * MiB;
constexpr size_t OFF_WXV = OFF_WXK + 8 * MiB;
constexpr size_t OFF_WXO = OFF_WXV + 8 * MiB;
constexpr size_t OFF_WGU = OFF_WXO + 8 * MiB;
constexpr size_t OFF_WD = OFF_WGU + 512 * MiB;
constexpr size_t OFF_XB = OFF_WD + 256 * MiB;
constexpr size_t OFF_RSA = OFF_XB + 64 * MiB;
constexpr size_t OFF_RSC = OFF_RSA + 1 * MiB;
constexpr size_t OFF_SSPB = OFF_RSC + 1 * MiB;
constexpr size_t OFF_CS = OFF_SSPB + 2 * MiB;
constexpr size_t OFF_MB = OFF_CS + 8 * MiB;
constexpr size_t OFF_KX = OFF_MB + 16 * MiB;
constexpr size_t OFF_VXT = OFF_KX + 16 * MiB;
constexpr size_t OFF_MT = OFF_VXT + 16 * MiB;
constexpr size_t OFF_NT = OFF_MT + 64 * MiB;
constexpr size_t OFF_SCR = OFF_NT + 64 * MiB;
constexpr size_t OFF_PROJ = OFF_SCR;
constexpr size_t OFF_DP = OFF_PROJ + 64 * MiB;
constexpr size_t OFF_RSQ = OFF_DP + 32 * MiB;
constexpr size_t OFF_RSKV = OFF_RSQ + 1 * MiB;
constexpr size_t OFF_QF = OFF_RSKV + 1 * MiB;
constexpr size_t OFF_KF = OFF_QF + 48 * MiB;
constexpr size_t OFF_VF = OFF_KF + 48 * MiB;
constexpr size_t OFF_CAT = OFF_VF + 32 * MiB;
constexpr size_t OFF_QX = OFF_CAT + 64 * MiB;
constexpr size_t OFF_SX = OFF_QX + 64 * MiB;
constexpr size_t OFF_P = OFF_SX + 128 * MiB;
constexpr size_t OFF_OX = OFF_P + 64 * MiB;
constexpr size_t END_A = OFF_OX + 64 * MiB;
constexpr size_t OFF_AFF = OFF_SCR;
constexpr size_t OFF_SLOT = OFF_AFF + 2 * MiB;
constexpr size_t OFF_GATE = OFF_SLOT + 2 * MiB;
constexpr size_t OFF_RSROW = OFF_GATE + 1 * MiB;
constexpr size_t OFF_XT = OFF_RSROW + 1 * MiB;
constexpr size_t OFF_ACT = OFF_XT + 128 * MiB;
constexpr size_t OFF_Y = OFF_ACT + 256 * MiB;
constexpr size_t END_B = OFF_Y + 128 * MiB;
constexpr size_t WS_NEED = END_A > END_B ? END_A : END_B;

constexpr int LDS_BYTES = 160 * 1024;
constexpr int NTHREADS = 512;

struct Params {
    const float* x; const float* mem; const int* pos; const float* norm_mix; const float* w_in; const float* q_norm; const float* kv_norm;
    const float* w_uq; const float* w_ukv; const float* w_pool; const float* pool_scale; const float* w_out; const float* norm_x; const float* mem_norm;
    const float* wx_q; const float* wx_kv; const float* wx_o; const float* norm_ffn; const float* w_router; const float* w_gate; const float* w_up;
    const float* w_down; const float* norm_final;
    float* out; unsigned char* ws;
    float inv_freq[32];
    int ph_lo, ph_hi;
};

typedef const __attribute__((address_space(4))) Params* KP;
__device__ __forceinline__ KP kargs() { const unsigned long long a = (unsigned long long)__builtin_amdgcn_kernarg_segment_ptr(); int lo = (int)(unsigned)a, hi = (int)(unsigned)(a >> 32);
    asm volatile("" : "+s"(lo), "+s"(hi)); return (KP)(((unsigned long long)(unsigned)hi << 32) | (unsigned long long)(unsigned)lo); }
__device__ __forceinline__ int lnd_v(int v) { asm volatile("" : "+v"(v)); return v; }
__device__ __forceinline__ int lnd_s(int v) { v = __builtin_amdgcn_readfirstlane(v); asm volatile("" : "+s"(v)); return v; }
template <class Tp> __device__ __forceinline__ Tp* lnd_p(Tp* q) { const unsigned long long a = (unsigned long long)q; int lo = __builtin_amdgcn_readfirstlane((int)(unsigned)a), hi = __builtin_amdgcn_readfirstlane((int)(unsigned)(a >> 32));
    asm volatile("" : "+s"(lo), "+s"(hi)); return (Tp*)(((unsigned long long)(unsigned)hi << 32) | (unsigned long long)(unsigned)lo); }
#define TID() (lnd_s(wv_) * 64 + (int)__builtin_amdgcn_mbcnt_hi(~0u, __builtin_amdgcn_mbcnt_lo(~0u, (unsigned)lnd_s(0))))
#define BID() lnd_s((int)blockIdx.x)
#define NBLK() lnd_s((int)gridDim.x)
__device__ __forceinline__ unsigned cvt_pk_bf16(float lo, float hi) { unsigned r; asm volatile("v_cvt_pk_bf16_f32 %0, %1, %2" : "=v"(r) : "v"(lo), "v"(hi)); return r; }
__device__ __forceinline__ float bf2f(unsigned short h) { return __uint_as_float((unsigned)h << 16); }
__device__ __forceinline__ float bflo(unsigned w) { return __uint_as_float(w << 16); }
__device__ __forceinline__ float bfhi(unsigned w) { return __uint_as_float(w & 0xffff0000u); }
template <int K> __device__ __forceinline__ float shx(float v) {
    if constexpr (K == 32) { const auto rr = __builtin_amdgcn_permlane32_swap(__float_as_uint(v), __float_as_uint(v), false, false);
        const bool lo = (int)__builtin_amdgcn_mbcnt_hi(~0u, __builtin_amdgcn_mbcnt_lo(~0u, (unsigned)lnd_s(0))) < 32; return __uint_as_float(lo ? rr[1] : rr[0]); }
    else return __uint_as_float((unsigned)__builtin_amdgcn_ds_swizzle((int)__float_as_uint(v), (K << 10) | 0x1f));
}
__device__ __forceinline__ float shx_sum32(float v) { const auto rr = __builtin_amdgcn_permlane32_swap(__float_as_uint(v), __float_as_uint(v), false, false); return __uint_as_float(rr[0]) + __uint_as_float(rr[1]); }
__device__ __forceinline__ float shx_max32(float v) { const auto rr = __builtin_amdgcn_permlane32_swap(__float_as_uint(v), __float_as_uint(v), false, false); return fmaxf(__uint_as_float(rr[0]), __uint_as_float(rr[1])); }
__device__ __forceinline__ float wave_sum(float v) { v = shx_sum32(v); v += shx<16>(v); v += shx<8>(v); v += shx<4>(v); v += shx<2>(v); v += shx<1>(v); return v; }
__device__ __forceinline__ float wave_max(float v) { v = shx_max32(v); v = fmaxf(v, shx<16>(v)); v = fmaxf(v, shx<8>(v)); v = fmaxf(v, shx<4>(v)); v = fmaxf(v, shx<2>(v)); v = fmaxf(v, shx<1>(v)); return v; }

#define XB_TMO      128
#define XB_XCNT(j)  (256  + 64 * (j))
#define XB_XSUB(j)  (1280 + 64 * (j))
#define XB_XGEN(j)  (2304 + 64 * (j))
#define XB_TOP      3328
#define XB_TOPGEN   3392
#define XCD_BAR_WORDS 3456
#define XB_SPIN_CAP (1u << 18)
#define LAS __attribute__((address_space(3)))

__device__ __forceinline__ unsigned xb_ld(unsigned* p)              { return __hip_atomic_load(p, __ATOMIC_RELAXED, __HIP_MEMORY_SCOPE_AGENT); }
__device__ __forceinline__ unsigned xb_add(unsigned* p, unsigned v) { return __hip_atomic_fetch_add(p, v, __ATOMIC_RELAXED, __HIP_MEMORY_SCOPE_AGENT); }
__device__ __forceinline__ unsigned xb_xcc_id() { return (unsigned)__builtin_amdgcn_s_getreg((3 << 11) | 20) & 0xFu; }
#define XB_SPIN(cond, bar) do { unsigned _sp = 0; while (cond) { __builtin_amdgcn_s_sleep(1); \
    if ((++_sp & 255u) == 0u) { if (xb_ld(&(bar)[XB_TMO])) break; if (_sp > XB_SPIN_CAP) { atomicAdd(&(bar)[XB_TMO], 1u); break; } } } } while (0)

struct XcdBarrier { unsigned* bar; unsigned x; volatile LAS unsigned* st; };

__device__ __forceinline__ XcdBarrier xcd_barrier_post(unsigned* bar, volatile LAS unsigned* st, const bool t0) {
    XcdBarrier b; b.bar = bar; b.x = xb_xcc_id(); b.st = st;
    if (t0) (void)xb_add(&bar[XB_XCNT(b.x)], 1u);
    return b;
}
__device__ __forceinline__ void xcd_barrier_complete(unsigned* bar, unsigned x, unsigned& nloc, unsigned& nx) {
    const unsigned G = gridDim.x * gridDim.y * gridDim.z;
    unsigned sum, cnt, mine, sp = 0u;
    for (;;) {
        sum = 0u; cnt = 0u; mine = 0u;
#pragma unroll
        for (unsigned j = 0; j < 16; ++j) { const unsigned c = xb_ld(&bar[XB_XCNT(j)]); sum += c; cnt += (c > 0u) ? 1u : 0u; mine = (j == x) ? c : mine; }
        if (sum == G) break;
        __builtin_amdgcn_s_sleep(1);
        if ((++sp & 255u) == 0u) { if (xb_ld(&bar[XB_TMO])) break; if (sp > XB_SPIN_CAP) { atomicAdd(&bar[XB_TMO], 1u); break; } }
    }
    nloc = mine > 0u ? mine : 1u; nx = cnt > 0u ? cnt : 1u;
}
__device__ __forceinline__ void xcd_barrier(const XcdBarrier& b, const bool t0) {
    asm volatile("s_waitcnt vmcnt(0)" ::: "memory");
    __syncthreads();
    if (t0) {
        unsigned* bar = b.bar;
        __builtin_amdgcn_s_waitcnt(0);
        unsigned nloc = b.st[0], nx = b.st[1];
        if (nloc == 0u) { xcd_barrier_complete(bar, b.x, nloc, nx); b.st[0] = nloc; b.st[1] = nx; }
        const unsigned old = xb_add(&bar[XB_XSUB(b.x)], 1u);
        const unsigned gen = old / nloc;
        if (old + 1u == (gen + 1u) * nloc) {
            __builtin_amdgcn_fence(__ATOMIC_RELEASE, "agent");
            asm volatile("s_waitcnt vmcnt(0)" ::: "memory");
            const unsigned og = xb_add(&bar[XB_TOP], 1u);
            const unsigned tg = og / nx;
            if (og + 1u == (tg + 1u) * nx) xb_add(&bar[XB_TOPGEN], 1u);
            else XB_SPIN(xb_ld(&bar[XB_TOPGEN]) == tg, bar);
            __builtin_amdgcn_fence(__ATOMIC_ACQUIRE, "agent");
            xb_add(&bar[XB_XGEN(b.x)], 1u);
            asm volatile("s_waitcnt vmcnt(0)" ::: "memory");
        } else {
            XB_SPIN(xb_ld(&bar[XB_XGEN(b.x)]) == gen, bar);
            __builtin_amdgcn_fence(__ATOMIC_ACQUIRE, "agent");
            asm volatile("s_waitcnt vmcnt(0)" ::: "memory");
        }
    }
    __syncthreads();
}

struct GU { int pm, pn; const bf16_t* a; const bf16_t* b; };


namespace pg8 {
constexpr int BK = 64, HALF = 128, HTB = HALF * BK * 2, STAGE_BYTES = 8 * HTB;
__device__ __forceinline__ int lds_byte(int r, int c) { const int st = (r >> 4) * 2 + (c >> 5), rr = r & 15, cc = c & 31, ob = rr * 64 + cc * 2; return st * 1024 + (ob ^ (((ob >> 9) & 1) << 5)); }
__device__ __forceinline__ int perm32(int rho) { const int n = rho >> 4, i = rho & 15; return 8 * (i >> 2) + 4 * n + (i & 3); }
__device__ __forceinline__ void stage_rc(int b, int& R, int& C) { const int st = b / 1024, sb = b % 1024, swz = sb ^ (((sb >> 9) & 1) << 5); R = (st >> 1) * 16 + swz / 64; C = (st & 1) * 32 + (swz % 64) / 2; }

template <class Desc, class Epi>
__device__ __forceinline__ void gemm_phase(const int wv_, LAS unsigned char* lds, const Desc& d, const Epi& E) {
    const int tid = TID(), wid = __builtin_amdgcn_readfirstlane(tid >> 6), lane = tid & 63, wr = wid >> 2, wc = wid & 3, fr = lane & 15, fq = lane >> 4;
    const int nt = d.K / BK; int bid_ = BID(); const int nblk = NBLK();
    if constexpr (Desc::HAS_BID0) bid_ -= d.bid0;
    const int bid = bid_;
    unsigned voffA[2], voffA1[2], voffB[2]; int Rr[2], Cc[2];
    const size_t kstep = (size_t)(BK * 2);
    const size_t hstepA = (size_t)HALF * d.lda * 2, hstepB = (size_t)HALF * d.ldb * 2;
#pragma unroll
    for (int i = 0; i < 2; ++i) { int R, C; stage_rc(tid * 16 + i * 8192, R, C); const int Rb = (R & ~31) + perm32(R & 31); Rr[i] = R; Cc[i] = C;
        voffA[i] = (unsigned)(R * d.lda + C) * 2u; voffA1[i] = voffA[i] + (unsigned)hstepA; voffB[i] = (unsigned)(Rb * d.ldb + C) * 2u; }
    unsigned voffAn[2] = {0u, 0u}, voffAn1[2] = {0u, 0u};
    LAS unsigned short* const tix = (LAS unsigned short*)(lds + STAGE_BYTES + 16384);
#define PG8_AOFF(ord, U, O0, O1) do { _Pragma("unroll") for (int _i = 0; _i < 2; ++_i) { \
        O0[_i] = d.rowbyte(U, (int)tix[(ord) * 256 + Rr[_i]]) + (unsigned)(Cc[_i] * 2); O1[_i] = d.rowbyte(U, (int)tix[(ord) * 256 + HALF + Rr[_i]]) + (unsigned)(Cc[_i] * 2); } } while (0)
    const unsigned ldsw = (unsigned)wid * 1024u;
    const int aoff = lds_byte(wr * 64 + fr, fq * 8), boff = lds_byte(wc * 32 + fr, fq * 8);
#define PG8_SA(b, h) (((b) * 2 + (h)) * HTB)
#define PG8_SB(b, h) ((4 + (b) * 2 + (h)) * HTB)
#define PG8_STAGE(bufoff, gbase, voff) do { _Pragma("unroll") for (int _i = 0; _i < 2; ++_i) \
        __builtin_amdgcn_global_load_lds((const unsigned*)((const char*)(gbase) + (voff)[_i]), (LAS unsigned*)(lds + (bufoff) + ldsw + _i * 8192), 16, 0, 0); } while (0)
#define PG8_LDA(dst, b, h) do { _Pragma("unroll") for (int m = 0; m < 4; ++m) _Pragma("unroll") for (int k = 0; k < 2; ++k) dst[m][k] = *(const LAS bf16x8*)(lds + PG8_SA(b, h) + aoff + m * 2048 + k * 1024); } while (0)
#define PG8_LDB(dst, b, h) do { _Pragma("unroll") for (int n = 0; n < 2; ++n) _Pragma("unroll") for (int k = 0; k < 2; ++k) dst[n][k] = *(const LAS bf16x8*)(lds + PG8_SB(b, h) + boff + n * 2048 + k * 1024); } while (0)
#define PG8_MMA(ai, bj, At, Bt) do { __builtin_amdgcn_s_setprio(1); _Pragma("unroll") for (int m = 0; m < 4; ++m) _Pragma("unroll") for (int n = 0; n < 2; ++n) _Pragma("unroll") for (int k = 0; k < 2; ++k) \
        acc[ai][bj][m][n] = __builtin_amdgcn_mfma_f32_16x16x32_bf16(Bt[n][k], At[m][k], acc[ai][bj][m][n], 0, 0, 0); __builtin_amdgcn_s_setprio(0); } while (0)
#define PG8_WAIT_V(n) asm volatile("s_waitcnt vmcnt(" #n ")" ::: "memory")
#define PG8_WAIT_L(n) asm volatile("s_waitcnt lgkmcnt(" #n ")" ::: "memory")
#define PG8_BAR __builtin_amdgcn_s_barrier()
#define PG8_SCHED __builtin_amdgcn_sched_barrier(0)
    GU cur, nxt; int ui = 0;
    if (bid < 0 || bid >= d.nunits) return;
    LAS float* const rsc = (LAS float*)(lds + STAGE_BYTES);
    if constexpr (Epi::STAGED || Desc::GATHER) {
        const int nmy = (d.nunits - bid + nblk - 1) / nblk;
        for (int idx = tid; idx < nmy * 256; idx += NTHREADS) { GU su; d.unit(bid + (idx >> 8) * nblk, su);
            if constexpr (Epi::STAGED) rsc[idx] = E.rowscale(su, idx & 255);
            if constexpr (Desc::GATHER) tix[idx] = (unsigned short)d.tokidx(su, idx & 255); }
        asm volatile("s_waitcnt vmcnt(0) lgkmcnt(0)" ::: "memory"); __builtin_amdgcn_s_barrier(); asm volatile("" ::: "memory");
    }
    d.unit(bid, cur);
    if constexpr (Desc::GATHER) PG8_AOFF(0, cur, voffA, voffA1);
    f32x4 acc[2][2][4][2];
#pragma unroll
    for (int a = 0; a < 2; ++a)
#pragma unroll
        for (int b = 0; b < 2; ++b)
#pragma unroll
            for (int m = 0; m < 4; ++m)
#pragma unroll
                for (int n = 0; n < 2; ++n) acc[a][b][m][n] = (f32x4){0.f, 0.f, 0.f, 0.f};
    bf16x8 At[4][2], B0[2][2], B1[2][2];
    const char* cA = (const char*)cur.a; const char* cB = (const char*)cur.b;
    PG8_STAGE(PG8_SB(0, 0), cB, voffB); PG8_STAGE(PG8_SB(0, 1), cB + hstepB, voffB); PG8_STAGE(PG8_SA(0, 0), cA, voffA); PG8_STAGE(PG8_SA(0, 1), cA, voffA1);
    if (wr == 1) PG8_BAR;
    PG8_WAIT_V(2); PG8_BAR;
    PG8_STAGE(PG8_SB(1, 0), cB + kstep, voffB); PG8_STAGE(PG8_SA(1, 0), cA + kstep, voffA); PG8_STAGE(PG8_SB(1, 1), cB + hstepB + kstep, voffB);
    PG8_WAIT_V(6); PG8_BAR;
    for (;;) {
        const int inext = bid + (ui + 1) * nblk; const bool has_next = inext < d.nunits;
        if (has_next) d.unit(inext, nxt);
        if constexpr (Desc::GATHER) { if (has_next) PG8_AOFF(ui + 1, nxt, voffAn, voffAn1); else { voffAn[0] = voffA[0]; voffAn[1] = voffA[1]; voffAn1[0] = voffA1[0]; voffAn1[1] = voffA1[1]; } }
        const char* nA = has_next ? (const char*)nxt.a : cA; const char* nB = has_next ? (const char*)nxt.b : cB;
        for (int t = 0; t < nt; t += 2) {
            const bool last = (t == nt - 2);
            unsigned sA0[2], sA1[2];
            if constexpr (Desc::GATHER) { sA0[0] = last ? voffAn[0] : voffA[0]; sA0[1] = last ? voffAn[1] : voffA[1]; sA1[0] = last ? voffAn1[0] : voffA1[0]; sA1[1] = last ? voffAn1[1] : voffA1[1]; }
            else { sA0[0] = voffA[0]; sA0[1] = voffA[1]; sA1[0] = voffA1[0]; sA1[1] = voffA1[1]; }
            const char* a1 = cA + (size_t)(t + 1) * kstep;
            const char* a2 = last ? nA : cA + (size_t)(t + 2) * kstep; const char* b2 = last ? nB : cB + (size_t)(t + 2) * kstep;
            const char* a3 = a2 + kstep; const char* b3 = b2 + kstep;
            PG8_LDB(B0, 0, 0); PG8_LDB(B1, 0, 1); PG8_SCHED; PG8_LDA(At, 0, 0); PG8_STAGE(PG8_SA(1, 1), a1, voffA1);
            PG8_WAIT_V(8); PG8_WAIT_L(0); PG8_BAR; PG8_MMA(0, 0, At, B0); PG8_MMA(0, 1, At, B1); PG8_BAR; PG8_SCHED;
            PG8_LDA(At, 0, 1); PG8_STAGE(PG8_SB(0, 0), b2, voffB); PG8_STAGE(PG8_SB(0, 1), b2 + hstepB, voffB); PG8_STAGE(PG8_SA(0, 0), a2, sA0);
            PG8_WAIT_V(8); PG8_WAIT_L(0); PG8_BAR; PG8_MMA(1, 0, At, B0); PG8_MMA(1, 1, At, B1); PG8_BAR; PG8_SCHED;
            PG8_LDB(B0, 1, 0); PG8_LDB(B1, 1, 1); PG8_SCHED; PG8_LDA(At, 1, 0); PG8_STAGE(PG8_SA(0, 1), a2, sA1);
            PG8_WAIT_V(8); PG8_WAIT_L(0); PG8_BAR; PG8_MMA(0, 0, At, B0); PG8_MMA(0, 1, At, B1); PG8_BAR; PG8_SCHED;
            PG8_LDA(At, 1, 1); PG8_STAGE(PG8_SB(1, 0), b3, voffB); PG8_STAGE(PG8_SB(1, 1), b3 + hstepB, voffB); PG8_STAGE(PG8_SA(1, 0), a3, sA0);
            PG8_WAIT_V(8); PG8_WAIT_L(0); PG8_BAR; PG8_MMA(1, 0, At, B0); PG8_MMA(1, 1, At, B1); PG8_BAR; PG8_SCHED;
        }
        if (wr == 0) PG8_BAR;
        E(acc, cur, wr, wc, fr, fq, rsc + ui * 256);
        if (!has_next) break;
#pragma unroll
        for (int a = 0; a < 2; ++a)
#pragma unroll
            for (int b = 0; b < 2; ++b)
#pragma unroll
                for (int m = 0; m < 4; ++m)
#pragma unroll
                    for (int n = 0; n < 2; ++n) acc[a][b][m][n] = (f32x4){0.f, 0.f, 0.f, 0.f};
        cur = nxt; cA = nA; cB = nB; ++ui;
        if constexpr (Desc::GATHER) { voffA[0] = voffAn[0]; voffA[1] = voffAn[1]; voffA1[0] = voffAn1[0]; voffA1[1] = voffAn1[1]; }
        if (wr == 1) PG8_BAR;
    }
    PG8_WAIT_V(0);
    PG8_BAR;
#undef PG8_AOFF
#undef PG8_SA
#undef PG8_SB
#undef PG8_STAGE
#undef PG8_LDA
#undef PG8_LDB
#undef PG8_MMA
#undef PG8_WAIT_V
#undef PG8_WAIT_L
#undef PG8_BAR
#undef PG8_SCHED
}
}
#ifndef GEMM_SIMPLE
#define GEMM_SIMPLE 0
#endif
#define GEMM(lds, d, E) pg8::gemm_phase(wv_, (LAS unsigned char*)(lds), d, E)

#define ACC_T const f32x4 (&acc)[2][2][4][2]
#define FOR_ACC _Pragma("unroll") for (int ai = 0; ai < 2; ++ai) _Pragma("unroll") for (int m = 0; m < 4; ++m) _Pragma("unroll") for (int bj = 0; bj < 2; ++bj) _Pragma("unroll") for (int n = 0; n < 2; ++n)
#define RLOC_OF (ai * 128 + wr * 64 + m * 16 + fr)
#define ROW_OF (u.pm * 256 + RLOC_OF)
#define COL_OF (u.pn * 256 + bj * 128 + wc * 32 + fq * 8 + n * 4)

__device__ __forceinline__ int xcd_major(int i, int nunits) { const int rd = i >> 8, b = i & 255; return ((rd + 1) * 256 <= nunits) ? (((rd * 8 + (b & 7)) << 5) + (b >> 3)) : i; }
struct DescPlain {
    static constexpr bool HAS_BID0 = false;
    static constexpr bool GATHER = false;
    const bf16_t* A; const bf16_t* Bt; int lda, ldb, K, nM, nN, nunits;
    __device__ __forceinline__ void unit(int i0, GU& u) const { const int i = xcd_major(i0, nunits); u.pm = i / nN; u.pn = i % nN; u.a = A + (size_t)u.pm * 256 * lda; u.b = Bt + (size_t)u.pn * 256 * ldb; }
};
struct DescKV {
    static constexpr bool HAS_BID0 = false;
    static constexpr bool GATHER = false;
    const bf16_t* mb; const bf16_t* Wk; const bf16_t* Wv; int lda, ldb, K, nunits;
    __device__ __forceinline__ void unit(int i, GU& u) const { const int which = i >> 7, r = i & 127, pml = r >> 2; u.pn = r & 3; const int l = pml >> 3; u.pm = which * 32 + pml;
        u.a = mb + (size_t)pml * 256 * 1024; u.b = (which ? Wv : Wk) + ((size_t)l * 1024 + u.pn * 256) * 1024; }
};
struct DescMt {
    static constexpr bool GATHER = false;
    static constexpr bool HAS_BID0 = true; const bf16_t* kx; const bf16_t* wq; int lda, ldb, K, nunits, lbase, bid0;
    __device__ __forceinline__ void unit(int i0, GU& u) const { const int i = i0 + lbase, l = i >> 7, r = i & 127, b = r >> 4, h = (r >> 2) & 3, nt = r & 3; u.pm = (l * NB + b) * 4 + h; u.pn = nt;
        u.a = kx + ((size_t)l * 2048 + b * 256) * 1024 + h * 256; u.b = wq + ((size_t)l * 1024 + nt * 256) * 1024 + h * 256; }
};
struct DescNt {
    static constexpr bool GATHER = false;
    static constexpr bool HAS_BID0 = true; const bf16_t* woT; const bf16_t* vx; int lda, ldb, K, nunits, lbase, bid0;
    __device__ __forceinline__ void unit(int i0, GU& u) const { const int i = i0 + lbase, l = i >> 7, r = i & 127, b = r >> 4, h = (r >> 2) & 3, nt = r & 3; u.pm = (l * NB + b) * 4 + nt; u.pn = h;
        u.a = woT + ((size_t)l * 1024 + nt * 256) * 1024 + h * 256; u.b = vx + ((size_t)l * 2048 + b * 256) * 1024 + h * 256; }
};
struct DescXB {
    static constexpr bool HAS_BID0 = false;
    static constexpr bool GATHER = false;
    static constexpr int STAGGER_TICKS = 0; const bf16_t* A; const bf16_t* Bt; int lda, ldb, K, nunits;
    __device__ __forceinline__ void unit(int i0, GU& u) const { const int i = xcd_major(i0, nunits); u.pm = i >> 2; u.pn = i & 3; const int b = u.pm >> 4;
        u.a = A + (size_t)u.pm * 256 * 1024; u.b = Bt + ((size_t)(b * 4 + u.pn) * 256) * 1024; }
};
struct DescGU {
    static constexpr bool HAS_BID0 = false;
    static constexpr bool GATHER = true;
    const bf16_t* xb; const int* tok; const bf16_t* W; int lda, ldb, K, nunits, base;
    __device__ __forceinline__ void unit(int i0, GU& u) const { const int i = i0 + base, e = i >> 8, j = i & 255, x = j & 7, r = j >> 3, pmi = (x >> 1) * 4 + (r >> 3); u.pn = (x & 1) * 8 + (r & 7); u.pm = ((pmi >> 1) * NE + e) * 2 + (pmi & 1);
        u.a = xb; u.b = W + ((size_t)e * 4096 + u.pn * 256) * 1024; }
    __device__ __forceinline__ int tokidx(const GU& u, int r) const { return tok[u.pm * 256 + r]; }
    __device__ __forceinline__ unsigned rowbyte(const GU& u, int sidx) const { return (unsigned)(((u.pm >> 5) * SEQ + sidx) * (DM * 2)); }
};
struct DescDown {
    static constexpr bool HAS_BID0 = false;
    static constexpr bool GATHER = false;
    const bf16_t* act; const bf16_t* W; int lda, ldb, K, nunits;
    __device__ __forceinline__ void unit(int i, GU& u) const { const int rd = i >> 8, j = i & 255, x = j & 7, r = j >> 3, e = NE - 1 - (rd * 4 + (x >> 1)), pmi = (x & 1) * 8 + (r >> 2);     u.pn = r & 3; u.pm = ((pmi >> 1) * NE + e) * 2 + (pmi & 1);
        u.a = act + (size_t)u.pm * 256 * 2048; u.b = W + ((size_t)e * 1024 + u.pn * 256) * 2048; }
};

__device__ __forceinline__ void st_bf16x4(bf16_t* p, f32x4 v) { u32x2 w; w.x = cvt_pk_bf16(v[0], v[1]); w.y = cvt_pk_bf16(v[2], v[3]); *(u32x2*)p = w; }

__device__ __forceinline__ void st_bf16x8(bf16_t* p, f32x4 a, f32x4 b) { u32x4 w; w.x = cvt_pk_bf16(a[0], a[1]); w.y = cvt_pk_bf16(a[2], a[3]); w.z = cvt_pk_bf16(b[0], b[1]); w.w = cvt_pk_bf16(b[2], b[3]); *(u32x4*)p = w; }
#define COL8_OF (u.pn * 256 + bj * 128 + wc * 32 + fq * 8)
struct EpiBf16 {
    bf16_t* O; int ldc; const float* rs; float scale; static constexpr bool STAGED = true;
    __device__ __forceinline__ float rowscale(const GU& u, int r) const { return (rs ? rs[u.pm * 256 + r] : 1.f) * scale; }
    __device__ __forceinline__ void operator()(ACC_T, const GU& u, int wr, int wc, int fr, int fq, const LAS float* sc) const {
#pragma unroll
        for (int ai = 0; ai < 2; ++ai)
#pragma unroll
            for (int m = 0; m < 4; ++m) { const int row = ROW_OF; const float s = sc[RLOC_OF];
#pragma unroll
                for (int bj = 0; bj < 2; ++bj) st_bf16x8(O + (size_t)row * ldc + COL8_OF, acc[ai][bj][m][0] * s, acc[ai][bj][m][1] * s); }
    }
};
struct EpiResid {
    const bf16_t* xin; bf16_t* xout; float* ssp; static constexpr bool STAGED = false;
    __device__ __forceinline__ void operator()(ACC_T, const GU& u, int wr, int wc, int fr, int fq, const LAS float* sc) const {
#pragma unroll
        for (int ai = 0; ai < 2; ++ai)
#pragma unroll
            for (int m = 0; m < 4; ++m) { const int row = ROW_OF; float ss = 0.f;
#pragma unroll
                for (int bj = 0; bj < 2; ++bj) { const size_t o = (size_t)row * 1024 + COL8_OF; const u32x4 xi = *(const u32x4*)(xin + o);
                        const f32x4 v0 = (f32x4){bflo(xi.x), bfhi(xi.x), bflo(xi.y), bfhi(xi.y)} + acc[ai][bj][m][0], v1 = (f32x4){bflo(xi.z), bfhi(xi.z), bflo(xi.w), bfhi(xi.w)} + acc[ai][bj][m][1];
                        st_bf16x8(xout + o, v0, v1);
                        ss += ((v0[0] * v0[0] + v0[1] * v0[1]) + (v0[2] * v0[2] + v0[3] * v0[3])) + ((v1[0] * v1[0] + v1[1] * v1[1]) + (v1[2] * v1[2] + v1[3] * v1[3])); }
                if (ssp) { ss += shx<16>(ss); ss = shx_sum32(ss); if (fq == 0) ssp[(size_t)row * 16 + u.pn * 4 + wc] = ss; } }
    }
};
struct EpiQ {
    bf16_t* Qf; const float* rsq; const f32x2* cs; static constexpr bool STAGED = true;
    __device__ __forceinline__ float rowscale(const GU& u, int r) const { return rsq[u.pm * 256 + r]; }
    __device__ __forceinline__ void operator()(ACC_T, const GU& u, int wr, int wc, int fr, int fq, const LAS float* sc) const {
#pragma unroll
        for (int ai = 0; ai < 2; ++ai)
#pragma unroll
            for (int m = 0; m < 4; ++m) { const int row = ROW_OF; const float s = sc[RLOC_OF]; const int b = row >> 12, sq = row & 4095;
#pragma unroll
                for (int bj = 0; bj < 2; ++bj)
#pragma unroll
                    for (int n = 0; n < 2; ++n) { const int col = COL_OF, h = col / 192, j = col - h * 192; f32x4 v = acc[ai][bj][m][n] * s;
                        if (j >= 128) { const int p0 = (j - 128) >> 1; const f32x4 c2 = *(const f32x4*)(cs + (size_t)row * 32 + p0);
                            const f32x4 r = {v[0] * c2[0] - v[1] * c2[1], v[0] * c2[1] + v[1] * c2[0], v[2] * c2[2] - v[3] * c2[3], v[2] * c2[3] + v[3] * c2[2]}; v = r; }
                        st_bf16x4(Qf + ((size_t)(b * NH + h) * SEQ + sq) * DQK + j, v); } }
    }
};
struct EpiSoftmax {
    bf16_t* P; LAS float* xs; const float* ssp; float scale;
    static constexpr bool STAGED = true;
    __device__ __forceinline__ float rowscale(const GU& u, int r) const { const f32x4* sp = (const f32x4*)(ssp + (size_t)(u.pm * 256 + r) * 16); const f32x4 a = sp[0], b = sp[1], c = sp[2], d = sp[3];
        const float ss = ((a[0] + a[1]) + (a[2] + a[3])) + ((b[0] + b[1]) + (b[2] + b[3])) + ((c[0] + c[1]) + (c[2] + c[3])) + ((d[0] + d[1]) + (d[2] + d[3])); return rsqrtf(ss * (1.0f / 1024.0f) + EPS) * scale; }
    __device__ __forceinline__ void operator()(f32x4 (&acc)[2][2][4][2], const GU& u, int wr, int wc, int fr, int fq, const LAS float* sc) const {
#pragma unroll
        for (int ai = 0; ai < 2; ++ai)
#pragma unroll
            for (int m = 0; m < 4; ++m) { float mx = -3.0e38f; const float s = sc[RLOC_OF];
#pragma unroll
                for (int bj = 0; bj < 2; ++bj)
#pragma unroll
                    for (int n = 0; n < 2; ++n) { const f32x4 v = acc[ai][bj][m][n] * s; acc[ai][bj][m][n] = v; mx = fmaxf(mx, fmaxf(fmaxf(v[0], v[1]), fmaxf(v[2], v[3]))); }
                mx = fmaxf(mx, shx<16>(mx)); mx = shx_max32(mx);
                if (fq == 0) xs[(ai * 128 + wr * 64 + m * 16 + fr) * 4 + wc] = mx; }
        asm volatile("s_waitcnt lgkmcnt(0)" ::: "memory"); __builtin_amdgcn_s_barrier(); asm volatile("" ::: "memory");
#pragma unroll
        for (int ai = 0; ai < 2; ++ai)
#pragma unroll
            for (int m = 0; m < 4; ++m) { const int rl = ai * 128 + wr * 64 + m * 16 + fr; const f32x4 r4 = *(const LAS f32x4*)(xs + rl * 4);
                const float M = fmaxf(fmaxf(r4[0], r4[1]), fmaxf(r4[2], r4[3])); float sum = 0.f;
#pragma unroll
                for (int bj = 0; bj < 2; ++bj)
#pragma unroll
                    for (int n = 0; n < 2; ++n) { f32x4 v = acc[ai][bj][m][n];
#pragma unroll
                        for (int q = 0; q < 4; ++q) { v[q] = __expf(v[q] - M); sum += v[q]; }
                        acc[ai][bj][m][n] = v; }
                sum += shx<16>(sum); sum = shx_sum32(sum);
                if (fq == 0) xs[1024 + rl * 4 + wc] = sum; }
        asm volatile("s_waitcnt lgkmcnt(0)" ::: "memory"); __builtin_amdgcn_s_barrier(); asm volatile("" ::: "memory");
#pragma unroll
        for (int ai = 0; ai < 2; ++ai)
#pragma unroll
            for (int m = 0; m < 4; ++m) { const int rl = ai * 128 + wr * 64 + m * 16 + fr; const f32x4 r4 = *(const LAS f32x4*)(xs + 1024 + rl * 4);
                const float inv = 1.f / ((r4[0] + r4[1]) + (r4[2] + r4[3])); const int row = u.pm * 256 + rl;
#pragma unroll
                for (int bj = 0; bj < 2; ++bj) st_bf16x8(P + (size_t)row * 1024 + COL8_OF, acc[ai][bj][m][0] * inv, acc[ai][bj][m][1] * inv); }
    }
};
struct EpiSwiglu {
    bf16_t* act; const float* rsrow; static constexpr bool STAGED = true;
    __device__ __forceinline__ float rowscale(const GU& u, int r) const { return rsrow[u.pm * 256 + r]; }
    __device__ __forceinline__ void operator()(ACC_T, const GU& u, int wr, int wc, int fr, int fq, const LAS float* sc) const {
#pragma unroll
        for (int ai = 0; ai < 2; ++ai)
#pragma unroll
            for (int m = 0; m < 4; ++m) { const int row = ROW_OF; const float s = sc[RLOC_OF];
                const float s2 = s * -1.4426950408889634f, is2 = __builtin_amdgcn_rcpf(s * s); const f32x2 S2 = {s2, s2}, IS2 = {is2, is2};
                f32x4 o[2];
#pragma unroll
                for (int n = 0; n < 2; ++n) { const f32x4 g = acc[ai][0][m][n], up = acc[ai][1][m][n];
#pragma unroll
                    for (int h = 0; h < 2; ++h) { const f32x2 gg = {g[2 * h], g[2 * h + 1]}, uu = {up[2 * h], up[2 * h + 1]};
                        const f32x2 t = gg * S2; const f32x2 e = {__builtin_amdgcn_exp2f(t.x), __builtin_amdgcn_exp2f(t.y)};
                        const f32x2 dn = __builtin_elementwise_fma(e, IS2, IS2); const f32x2 r = {__builtin_amdgcn_rcpf(dn.x), __builtin_amdgcn_rcpf(dn.y)};
                        const f32x2 oo = (gg * uu) * r; o[n][2 * h] = oo.x; o[n][2 * h + 1] = oo.y; } }
                st_bf16x8(act + (size_t)row * DE + u.pn * 128 + wc * 32 + fq * 8, o[0], o[1]); }
    }
};

namespace att {
constexpr int NW = 8, QBLK = 32, KVBLK = 64;
constexpr float SCALE = 0.07216878364870322f;
constexpr float THR = 8.f;
constexpr int LDQ = DQK, LDK = DQK, LDV = DQK, LDO = 1024;
constexpr int SHM_V = KVBLK * DV * 2, SHM_K = KVBLK * 400, SHM_ATTN = 2 * SHM_K + NW * 64 * 4;
#define KPITCH 400
#define KSWZ(row, colB) ((row) * KPITCH + (colB))
#define SBAR() __builtin_amdgcn_sched_barrier(0)
__device__ __forceinline__ int crow(int r, int hi) { return (r & 3) + 8 * (r >> 2) + 4 * hi; }
__device__ __forceinline__ void partialSM(f32x16& p0, f32x16& p1, float& m_reg, float& mn, float& alpha) {
    constexpr float C = SCALE * 1.4426950408889634f;
    float pmax = p0[0];
#pragma unroll
    for (int r = 1; r < 16; ++r) pmax = fmaxf(pmax, p0[r]);
#pragma unroll
    for (int r = 0; r < 16; ++r) pmax = fmaxf(pmax, p1[r]);
    { auto rr = __builtin_amdgcn_permlane32_swap(__float_as_uint(pmax), __float_as_uint(pmax), false, false);
      pmax = fmaxf(__uint_as_float(rr[0]), __uint_as_float(rr[1])); }
    if (__builtin_expect(__all(pmax - m_reg <= THR / SCALE), 1)) { mn = m_reg; alpha = 1.f; }
    else { mn = fmaxf(m_reg, pmax); alpha = __builtin_amdgcn_exp2f((m_reg - mn) * C); m_reg = mn; }
    const float mnC = -mn * C;
#pragma unroll
    for (int r = 0; r < 16; ++r) p0[r] = fmaf(p0[r], C, mnC);
#pragma unroll
    for (int r = 0; r < 16; ++r) p1[r] = fmaf(p1[r], C, mnC);
#pragma unroll
    for (int r = 0; r < 16; ++r) p0[r] = __builtin_amdgcn_exp2f(p0[r]);
}
__device__ __forceinline__ void finishSM(f32x16& p0, f32x16& p1, float alpha, float& l_reg, bf16x8& pa0, bf16x8& pa1, bf16x8& pa2, bf16x8& pa3) {
#pragma unroll
    for (int r = 0; r < 16; ++r) p1[r] = __builtin_amdgcn_exp2f(p1[r]);
    float ps = 0;
#pragma unroll
    for (int r = 0; r < 16; ++r) ps += p0[r];
#pragma unroll
    for (int r = 0; r < 16; ++r) ps += p1[r];
    { auto rr = __builtin_amdgcn_permlane32_swap(__float_as_uint(ps), __float_as_uint(ps), false, false);
      ps = __uint_as_float(rr[0]) + __uint_as_float(rr[1]); }
    l_reg = l_reg * alpha + ps;
#define PK4(P, BASE, OUT) do { unsigned a0 = cvt_pk_bf16(P[BASE + 0], P[BASE + 1]), a1 = cvt_pk_bf16(P[BASE + 2], P[BASE + 3]);   \
    unsigned b0 = cvt_pk_bf16(P[BASE + 4], P[BASE + 5]), b1 = cvt_pk_bf16(P[BASE + 6], P[BASE + 7]);                              \
    auto r0 = __builtin_amdgcn_permlane32_swap(a0, b0, false, false); auto r1 = __builtin_amdgcn_permlane32_swap(a1, b1, false, false); \
    u32x4 w = {r0[0], r1[0], r0[1], r1[1]}; OUT = *reinterpret_cast<bf16x8*>(&w); } while (0)
    PK4(p0, 0, pa0); PK4(p0, 8, pa1); PK4(p1, 0, pa2); PK4(p1, 8, pa3);
#undef PK4
}
template <int OFF> __device__ __forceinline__ bf16x8 k_read(int kb) { bf16x8 r; asm volatile("ds_read_b128 %0, %1 offset:%2" : "=&v"(r) : "v"(kb), "i"(OFF) : "memory"); return r; }
#define K_WAIT(N, A, B) asm volatile("s_waitcnt lgkmcnt(" #N ")" : "+v"(A), "+v"(B) :: "memory")
__device__ __forceinline__ void qkt(f32x16& p0, f32x16& p1, const unsigned char* Ks, const bf16x8* qr, int r32, int hi) {
    const int kb = (int)(uintptr_t)Ks + r32 * KPITCH + hi * 16;
    constexpr int R1 = 32 * KPITCH;
    p0 = f32x16{}; p1 = f32x16{};
    bf16x8 a0 = k_read<0>(kb), a1 = k_read<R1>(kb), a2 = k_read<32>(kb), a3 = k_read<R1 + 32>(kb), a4 = k_read<64>(kb), a5 = k_read<R1 + 64>(kb);
#define QK_STEP(D, X, Y, NEXT, N) do { K_WAIT(N, X, Y); \
        p0 = __builtin_amdgcn_mfma_f32_32x32x16_bf16(X, qr[D], p0, 0, 0, 0); p1 = __builtin_amdgcn_mfma_f32_32x32x16_bf16(Y, qr[D], p1, 0, 0, 0); \
        if constexpr ((NEXT) < 12) { X = k_read<(NEXT) * 32>(kb); Y = k_read<R1 + (NEXT) * 32>(kb); } } while (0)
    QK_STEP(0, a0, a1, 3, 4); QK_STEP(1, a2, a3, 4, 4); QK_STEP(2, a4, a5, 5, 4);
    QK_STEP(3, a0, a1, 6, 4); QK_STEP(4, a2, a3, 7, 4); QK_STEP(5, a4, a5, 8, 4);
    QK_STEP(6, a0, a1, 9, 4); QK_STEP(7, a2, a3, 10, 4); QK_STEP(8, a4, a5, 11, 4);
    QK_STEP(9, a0, a1, 12, 4); QK_STEP(10, a2, a3, 12, 2); QK_STEP(11, a4, a5, 12, 0);
#undef QK_STEP
}
__device__ __forceinline__ int v_st(int k, int c) { const int kk = (k & ~0xC) | ((k & 4) << 1) | ((k & 8) >> 1); return ((kk >> 3) * 4 + (c >> 5)) * 512 + ((kk & 7) * 32 + (c & 31)) * 2; }
__device__ __forceinline__ int v_rd_base(int lane) { const int g = lane >> 4, c = lane & 15; return (8 * (g >> 1) + (c >> 2)) * KPITCH + (16 * (g & 1) + 4 * (c & 3)) * 2; }
constexpr int v_rd_off(int d0, int ks, int half) { return d0 * 64 + ks * (16 * KPITCH) + half * (4 * KPITCH); }
template <int OFF> __device__ __forceinline__ s16x4 tr_read(int vb) {
    s16x4 r; asm volatile("ds_read_b64_tr_b16 %0, %1 offset:%2" : "=&v"(r) : "v"(vb), "i"(OFF) : "memory"); return r;
}
#define PV_READ(D0, L0, H0, L1, H1, L2, H2, L3, H3) do { L0 = tr_read<v_rd_off(D0, 0, 0)>(vb); H0 = tr_read<v_rd_off(D0, 0, 1)>(vb); L1 = tr_read<v_rd_off(D0, 1, 0)>(vb); H1 = tr_read<v_rd_off(D0, 1, 1)>(vb); \
    L2 = tr_read<v_rd_off(D0, 2, 0)>(vb); H2 = tr_read<v_rd_off(D0, 2, 1)>(vb); L3 = tr_read<v_rd_off(D0, 3, 0)>(vb); H3 = tr_read<v_rd_off(D0, 3, 1)>(vb); } while (0)
#define PK(L, H) (bf16x8){L[0], L[1], L[2], L[3], H[0], H[1], H[2], H[3]}
#define PV_MMA(od, L0, H0, L1, H1, L2, H2, L3, H3) do { od = __builtin_amdgcn_mfma_f32_32x32x16_bf16(pa0, PK(L0, H0), od, 0, 0, 0); od = __builtin_amdgcn_mfma_f32_32x32x16_bf16(pa1, PK(L1, H1), od, 0, 0, 0); \
    od = __builtin_amdgcn_mfma_f32_32x32x16_bf16(pa2, PK(L2, H2), od, 0, 0, 0); od = __builtin_amdgcn_mfma_f32_32x32x16_bf16(pa3, PK(L3, H3), od, 0, 0, 0); } while (0)
__device__ __forceinline__ void pv_d0(f32x16* o, int vb, bf16x8 pa0, bf16x8 pa1, bf16x8 pa2, bf16x8 pa3) {
    s16x4 a0, a1, a2, a3, a4, a5, a6, a7, b0, b1, b2, b3, b4, b5, b6, b7;
    PV_READ(0, a0, a1, a2, a3, a4, a5, a6, a7);
    PV_READ(1, b0, b1, b2, b3, b4, b5, b6, b7);
    asm volatile("s_waitcnt lgkmcnt(8)" ::: "memory"); SBAR();
    PV_MMA(o[0], a0, a1, a2, a3, a4, a5, a6, a7); SBAR();
    PV_READ(2, a0, a1, a2, a3, a4, a5, a6, a7);
    asm volatile("s_waitcnt lgkmcnt(8)" ::: "memory"); SBAR();
    PV_MMA(o[1], b0, b1, b2, b3, b4, b5, b6, b7); SBAR();
    PV_READ(3, b0, b1, b2, b3, b4, b5, b6, b7);
    asm volatile("s_waitcnt lgkmcnt(8)" ::: "memory"); SBAR();
    PV_MMA(o[2], a0, a1, a2, a3, a4, a5, a6, a7); SBAR();
    asm volatile("s_waitcnt lgkmcnt(0)" ::: "memory"); SBAR();
    PV_MMA(o[3], b0, b1, b2, b3, b4, b5, b6, b7);
}
#undef PK
template <int VAR> __device__ __forceinline__ void attn_dense_body(const int wv_, const bf16_t* __restrict__ Qb, const bf16_t* __restrict__ Kh, const bf16_t* __restrict__ Vh, bf16_t* __restrict__ Ob, int seq, unsigned char* lds) {
    const int tid = TID(), wid = tid >> 6, lane = tid & 63, r32 = lane & 31, hi = lane >> 5;
    unsigned char* K_lds = lds;
    float* ws = (float*)(lds + 2 * SHM_K) + wid * 64; float* li_l = ws; float* al_l = ws + 32;
    float m_reg = -1e30f, l_reg = 0; f32x16 o[4] = {}; bf16x8 qr[12];
    const bf16_t* Qw = Qb + (long)(wid * QBLK + r32) * LDQ + hi * 8;
#pragma unroll
    for (int d0 = 0; d0 < 12; ++d0) qr[d0] = *(const bf16x8*)(Qw + d0 * 16);
    int kg[3], kl[3];
#pragma unroll
    for (int i = 0; i < 3; ++i) { const int id = tid + 512 * i, row = id / 24, ch = id % 24; kg[i] = row * LDK + ch * 8; kl[i] = KSWZ(row, ch * 16); }
    const int vb0 = (int)(uintptr_t)K_lds + v_rd_base(lane);
    bf16x8 ks0, ks1, ks2;
#define SLOAD(k0) do { \
    ks0 = *(const bf16x8*)(&Kh[(long)(k0) * LDK + kg[0]]); ks1 = *(const bf16x8*)(&Kh[(long)(k0) * LDK + kg[1]]); ks2 = *(const bf16x8*)(&Kh[(long)(k0) * LDK + kg[2]]); } while (0)
#define SWRITE(b) do { \
    *(bf16x8*)(K_lds + (b) * SHM_K + kl[0]) = ks0; *(bf16x8*)(K_lds + (b) * SHM_K + kl[1]) = ks1; *(bf16x8*)(K_lds + (b) * SHM_K + kl[2]) = ks2; } while (0)
#define SWAIT() asm volatile("s_waitcnt vmcnt(0)" ::: "memory")
#define RESC(a) do { if (__any((a) < 1.f)) { if (hi == 0) al_l[r32] = (a); asm volatile("s_waitcnt lgkmcnt(0)" ::: "memory"); \
    _Pragma("unroll") for (int d = 0; d < 4; ++d) _Pragma("unroll") for (int r = 0; r < 16; ++r) o[d][r] *= al_l[crow(r, hi)]; } } while (0)
    f32x16 p0, p1; float mn, al; bf16x8 pa0, pa1, pa2, pa3; const int NT = seq / KVBLK;
    SLOAD(0); SWAIT(); SWRITE(0); SLOAD(KVBLK);
    for (int j = 0; j < NT; ++j) {
        __syncthreads();
        if (j + 1 < NT) { SWAIT(); SWRITE((j + 1) & 1); if (j + 2 < NT) SLOAD((j + 2) * KVBLK); }
        const int bsel = j & 1;
        if constexpr (VAR != 3) qkt(p0, p1, K_lds + bsel * SHM_K, qr, r32, hi); else { p0 = o[0] * 0.5f; p1 = o[1] * 0.25f; }
        if constexpr (VAR != 2) { partialSM(p0, p1, m_reg, mn, al);
        RESC(al);
        finishSM(p0, p1, al, l_reg, pa0, pa1, pa2, pa3); SBAR(); }
        else { u32x4 w0 = {__float_as_uint(p0[0]), __float_as_uint(p0[1]), __float_as_uint(p0[2]), __float_as_uint(p0[3])}, w1 = {__float_as_uint(p0[4]), __float_as_uint(p1[1]), __float_as_uint(p1[2]), __float_as_uint(p1[3])};
               pa0 = *reinterpret_cast<bf16x8*>(&w0); pa1 = *reinterpret_cast<bf16x8*>(&w1); pa2 = pa0; pa3 = pa1; l_reg += p0[5] + p1[7] + p0[9] + p1[11] + p0[13] + p1[15] + p0[6] + p1[8] + p0[10] + p1[12] + p0[14] + p1[0] + p0[7] + p0[8] + p0[11] + p0[12] + p0[15] + p1[4] + p1[5] + p1[6] + p1[9] + p1[10] + p1[13] + p1[14]; SBAR(); }
        if constexpr (VAR != 1) pv_d0(o, vb0 + bsel * SHM_K, pa0, pa1, pa2, pa3); else { o[0][0] += __uint_as_float((unsigned)pa0[0] << 16) + __uint_as_float((unsigned)pa1[1] << 16) + __uint_as_float((unsigned)pa2[2] << 16) + __uint_as_float((unsigned)pa3[3] << 16); }
    }
    if (hi == 0) li_l[r32] = l_reg; asm volatile("s_waitcnt lgkmcnt(0)" ::: "memory");
    float rli[16];
#pragma unroll
    for (int r = 0; r < 16; ++r) rli[r] = __builtin_amdgcn_rcpf(li_l[crow(r, hi)]);
    bf16_t* Ow = Ob + (long)(wid * QBLK) * LDO;
    unsigned char* ost = lds + 90112 + wid * 8704;
#pragma unroll
    for (int r = 0; r < 16; ++r) { const int orow = crow(r, hi);
#pragma unroll
        for (int d0 = 0; d0 < 4; ++d0) *(bf16_t*)(ost + orow * 272 + (d0 * 32 + r32) * 2) = (bf16_t)(cvt_pk_bf16(o[d0][r] * rli[r], 0.f) & 0xffffu); }
    asm volatile("s_waitcnt lgkmcnt(0)" ::: "memory");
#pragma unroll
    for (int i = 0; i < 8; ++i) { const int row = (lane >> 4) + 4 * i; const u32x4 w = *(const u32x4*)(ost + row * 272 + (lane & 15) * 16); *(u32x4*)(Ow + (long)row * LDO + (lane & 15) * 8) = w; }
    __syncthreads();
#undef SLOAD
#undef SWRITE
#undef SWAIT
#undef RESC
}
}

__device__ __forceinline__ void sincos_acc(float af, float& c, float& s) {
    const double a = (double)af;
    const double kq = rint(a * 0.63661977236758134308);
    double r = fma(-kq, 1.5707963267948966, a); r = fma(-kq, 6.123233995736766e-17, r);
    const int q = ((int)kq) & 3;
    const double r2 = r * r;
    double sp = -1.0 / 6227020800.0 * -1.0;
    sp = fma(sp, r2, -1.0 / 39916800.0); sp = fma(sp, r2, 1.0 / 362880.0); sp = fma(sp, r2, -1.0 / 5040.0); sp = fma(sp, r2, 1.0 / 120.0); sp = fma(sp, r2, -1.0 / 6.0); sp = fma(sp, r2, 1.0);
    const double sr = sp * r;
    double cp = -1.0 / 87178291200.0;
    cp = fma(cp, r2, 1.0 / 479001600.0); cp = fma(cp, r2, -1.0 / 3628800.0); cp = fma(cp, r2, 1.0 / 40320.0); cp = fma(cp, r2, -1.0 / 720.0); cp = fma(cp, r2, 1.0 / 24.0); cp = fma(cp, r2, -0.5); cp = fma(cp, r2, 1.0);
    const double cr = cp;
    double cc, ssn;
    if (q == 0) { cc = cr; ssn = sr; } else if (q == 1) { cc = -sr; ssn = cr; } else if (q == 2) { cc = -cr; ssn = -sr; } else { cc = sr; ssn = -cr; }
    c = (float)cc; s = (float)ssn;
}

__device__ __forceinline__ void conv_job(const int wv_, unsigned char* lds, const float* src, const float* src2, int ldsrc, int coff, bf16_t* dst, int K, int ndst, const float* gk, const float* sn, int mode) {
    float* tile = (float*)lds;
    const int tid = TID(), tk = K / 64, tn = ndst / 64, ntile = tk * tn;
    for (int t = BID(); t < ntile; t += NBLK()) {
        const int nb = (t / tk) * 64, kb = (t % tk) * 64;
        if (mode == 1 && (nb % 192) < 128) continue;
        const int nl = tid & 63, np = nb + nl;
        const float* sp = src; int col = coff + np; bool zero = false; float scl = 1.f;
        if (mode == 1) { const int h = np / 192, j = np - h * 192; col = (j < 128) ? np : h * 192 + 128 + ((j - 128) >> 1) + 32 * ((j - 128) & 1); }
        else if (mode == 2) { const int pn = np >> 8, j = np & 255; if (j >= 128) { sp = src2; col = pn * 128 + (j - 128); } else col = pn * 128 + j; }
        else if (mode == 3) { const int g = np >> 7; zero = (kb >> 7) != g; col = (np & 127); sp = src + (size_t)g * 128 * 128 - (size_t)(g * 128) * 128; scl = sn[np]; }
        else if (mode == 4) { zero = np >= DIN; }
        __syncthreads();
#pragma unroll
        for (int i = 0; i < 8; ++i) { const int kl = (tid >> 6) + 8 * i, k = kb + kl;
            float v = 0.f;
            if (!zero) { if (mode == 3) v = src[((size_t)(np >> 7) * 128 + (k & 127)) * 128 + col] * scl; else v = sp[(size_t)k * ldsrc + col] * (gk ? gk[k] : 1.f); }
            tile[kl * 65 + nl] = v; }
        __syncthreads();
        { const int nn = tid >> 3, kc = (tid & 7) * 8; float v[8];
#pragma unroll
          for (int j = 0; j < 8; ++j) v[j] = tile[(kc + j) * 65 + nn];
          u32x4 w; w.x = cvt_pk_bf16(v[0], v[1]); w.y = cvt_pk_bf16(v[2], v[3]); w.z = cvt_pk_bf16(v[4], v[5]); w.w = cvt_pk_bf16(v[6], v[7]);
          *(u32x4*)(dst + (size_t)(nb + nn) * K + kb + kc) = w; }
    }
    __syncthreads();
}

struct CTile { const float* sa; const float* sb; const float* gk; bf16_t* dst; int ld, K, nb, kb, nlim; };
constexpr int CT_MOE = NL * NE * 384, CT_SQ = NL * 4 * 64, CT_UKV = 0, CT_TOTAL = CT_MOE + CT_SQ + CT_UKV;
__device__ __forceinline__ void conv_decode(KP p, unsigned char* ws, int idx, CTile& c) {
    c.nlim = 1 << 30; c.gk = nullptr;
    if (idx < CT_MOE) { const int le = idx / 384, r = idx - le * 384, l = le / NE;
        if (r < 256) { const int nt = r >> 4, kt = r & 15; c.sa = p->w_gate + (size_t)le * DM * DE + nt * 128; c.sb = p->w_up + (size_t)le * DM * DE + nt * 128; c.ld = DE; c.K = 1024; c.gk = p->norm_ffn + l * DM;
            c.dst = (bf16_t*)(ws + OFF_WGU) + (size_t)le * 4096 * 1024; c.nb = nt * 256; c.kb = kt * 64; }
        else { const int r2 = r - 256, nt = r2 >> 5, kt = r2 & 31; c.sa = p->w_down + (size_t)le * DE * DM + nt * 256; c.sb = c.sa + 128; c.ld = DM; c.K = 2048;
            c.dst = (bf16_t*)(ws + OFF_WD) + (size_t)le * 1024 * 2048; c.nb = nt * 256; c.kb = kt * 64; }
    } else if (idx < CT_MOE + CT_SQ) { const int r = idx - CT_MOE, l = r >> 8, q = (r >> 6) & 3, tt = r & 63, nt = tt >> 4, kt = tt & 15; c.K = 1024; c.nb = nt * 256; c.kb = kt * 64; c.ld = DM;
        const float* src; size_t doff;
        if (q == 0) { src = p->w_in + (size_t)l * DM * DIN; c.ld = DIN; c.gk = p->norm_mix + l * DM; c.nlim = DIN; doff = OFF_WIN; }
        else if (q == 1) { src = p->wx_kv + (size_t)l * DM * 2048; c.ld = 2048; doff = OFF_WXK; }
        else if (q == 2) { src = p->wx_kv + (size_t)l * DM * 2048 + 1024; c.ld = 2048; doff = OFF_WXV; }
        else { src = p->wx_o + (size_t)l * DM * DM; doff = OFF_WXO; }
        c.sa = src + nt * 256; c.sb = c.sa + 128; c.dst = (bf16_t*)(ws + doff) + (size_t)l * DM * DM;
    } else { const int r = idx - CT_MOE - CT_SQ, l = r >> 3, tt = r & 7, nt = tt >> 1, kt = tt & 1; c.K = 128; c.nb = nt * 256; c.kb = kt * 64; c.ld = 1024; c.gk = p->kv_norm + l * KVLORA;
        c.sa = p->w_ukv + (size_t)l * KVLORA * 1024 + nt * 256; c.sb = c.sa + 128; c.dst = (bf16_t*)(ws + OFF_WUKV) + (size_t)l * 1024 * 128; }
}
__device__ __forceinline__ void conv_load(const CTile& c, int wid, int lane, f32x4 (&r)[8], float (&g)[8]) {
    const float* base = (lane < 32 ? c.sa : c.sb) + (lane & 31) * 4; const bool ok = (c.nb + lane * 4) < c.nlim;
#pragma unroll
    for (int i = 0; i < 8; ++i) { const int k = c.kb + wid + 8 * i; r[i] = ok ? *(const f32x4*)(base + (size_t)k * c.ld) : (f32x4){0.f, 0.f, 0.f, 0.f}; g[i] = c.gk ? c.gk[k] : 1.f; }
}
#define CONV_BAR() do { asm volatile("s_waitcnt lgkmcnt(0)" ::: "memory"); __builtin_amdgcn_s_barrier(); asm volatile("" ::: "memory"); } while (0)
#define CONV_TILE(C, R, G) do { CONV_BAR(); \
        _Pragma("unroll") for (int i = 0; i < 8; ++i) { const int kl = wid + 8 * i; *(f32x4*)(tile + kl * 260 + ((lane * 4) ^ (((kl >> 3) & 7) << 2))) = R[i] * G[i]; } \
        CONV_BAR(); } while (0)
#define CONV_OUT(C) do { _Pragma("unroll") for (int i = 0; i < 4; ++i) { const int n = nn + 64 * i; float v[8]; \
            _Pragma("unroll") for (int j = 0; j < 8; ++j) v[j] = tile[(8 * kc + j) * 260 + (n ^ (kc << 2))]; \
            u32x4 w; w.x = cvt_pk_bf16(v[0], v[1]); w.y = cvt_pk_bf16(v[2], v[3]); w.z = cvt_pk_bf16(v[4], v[5]); w.w = cvt_pk_bf16(v[6], v[7]); \
            *(u32x4*)(C.dst + (size_t)(C.nb + n) * C.K + C.kb + 8 * kc) = w; } } while (0)
__device__ __forceinline__ void conv_fast(const int wv_, KP p, unsigned char* ws, unsigned char* lds, const int idx0, const int idx1) {
    float* tile = (float*)lds;
    const int tid = TID(), wid = tid >> 6, lane = tid & 63, kc = tid & 7, nn = tid >> 3;
    const int nblk = NBLK(); int idx = idx0 + BID();
    CTile cA, cB; f32x4 rA[8], rB[8]; float gA[8], gB[8];
    if (idx < idx1) { conv_decode(p, ws, idx, cA); conv_load(cA, wid, lane, rA, gA); }
    if (idx + nblk < idx1) { conv_decode(p, ws, idx + nblk, cB); conv_load(cB, wid, lane, rB, gB); }
    for (; idx < idx1; idx += 2 * nblk) {
        { CTile c = cA; CONV_TILE(c, rA, gA);
          if (idx + 2 * nblk < idx1) { conv_decode(p, ws, idx + 2 * nblk, cA); conv_load(cA, wid, lane, rA, gA); }
          CONV_OUT(c); }
        if (idx + nblk < idx1) { CTile c = cB; CONV_TILE(c, rB, gB);
          if (idx + 3 * nblk < idx1) { conv_decode(p, ws, idx + 3 * nblk, cB); conv_load(cB, wid, lane, rB, gB); }
          CONV_OUT(c); }
    }
    __syncthreads();
}
#undef CONV_TILE
#undef CONV_OUT
#undef CONV_BAR

__device__ __forceinline__ void phase_prologue(const int wv_, KP p, unsigned char* lds) {
    unsigned char* ws = lnd_p(p->ws);
    conv_fast(wv_, p, ws, lds, 0, NE * 384);
    conv_fast(wv_, p, ws, lds, CT_MOE, CT_TOTAL);
    { bf16_t* wq = (bf16_t*)(ws + OFF_WXQ);
      for (int i = BID() * NTHREADS + TID(); i < NL * DM * DM / 8; i += NBLK() * NTHREADS) { const int lk = i >> 7; const float g = p->norm_x[lk];
          const f32x4 a = *(const f32x4*)(p->wx_q + (size_t)i * 8), b = *(const f32x4*)(p->wx_q + (size_t)i * 8 + 4); st_bf16x8(wq + (size_t)i * 8, a * g, b * g); } }
    for (int l = 0; l < NL; ++l) {
        conv_job(wv_, lds, p->w_uq + (size_t)l * QLORA * 768, nullptr, 768, 0, (bf16_t*)(ws + OFF_WUQ) + (size_t)l * 768 * 256, 256, 768, p->q_norm + l * QLORA, nullptr, 1);
    }
    const int tid = TID(), wid = tid >> 6, lane = tid & 63, gw = BID() * 8 + wid, nw = NBLK() * 8;
    { bf16_t* xb = (bf16_t*)(ws + OFF_XB); float* rsA = (float*)(ws + OFF_RSA);
      for (int t = gw; t < T; t += nw) { float ss = 0.f;
#pragma unroll
          for (int i = 0; i < 4; ++i) { const f32x4 v = *(const f32x4*)(p->x + (size_t)t * DM + i * 256 + lane * 4); ss += (v[0] * v[0] + v[1] * v[1]) + (v[2] * v[2] + v[3] * v[3]); st_bf16x4(xb + (size_t)t * DM + i * 256 + lane * 4, v); }
          ss = wave_sum(ss); if (lane == 0) rsA[t] = rsqrtf(ss * (1.f / DM) + EPS); } }
    { bf16_t* mb = (bf16_t*)(ws + OFF_MB);
      for (int r = gw; r < NB * NMEM; r += nw) { f32x4 v[4]; float ss = 0.f;
#pragma unroll
          for (int i = 0; i < 4; ++i) { v[i] = *(const f32x4*)(p->mem + (size_t)r * DM + i * 256 + lane * 4); ss += (v[i][0] * v[i][0] + v[i][1] * v[i][1]) + (v[i][2] * v[i][2] + v[i][3] * v[i][3]); }
          ss = wave_sum(ss); const float rs = rsqrtf(ss * (1.f / DM) + EPS);
          for (int l = 0; l < NL; ++l)
#pragma unroll
              for (int i = 0; i < 4; ++i) { const f32x4 g = *(const f32x4*)(p->mem_norm + l * DM + i * 256 + lane * 4); st_bf16x4(mb + ((size_t)l * 2048 + r) * DM + i * 256 + lane * 4, v[i] * rs * g); } } }
    { f32x2* cs = (f32x2*)(ws + OFF_CS);
      for (int i = BID() * NTHREADS + tid; i < T * 32; i += NBLK() * NTHREADS) { const int t = i >> 5, pp = i & 31; const float ang = (float)p->pos[t] * p->inv_freq[pp]; float c, s; sincos_acc(ang, c, s); cs[i] = (f32x2){c, s}; } }
}

__device__ __forceinline__ void phase_weff(const int wv_, KP p, unsigned char* lds) {
    float* tx = (float*)lds;
    float* ty = tx + 128 * 68;
    const int tid = TID(); bf16_t* woutT = (bf16_t*)(lnd_p(p->ws) + OFF_WOUT); bf16_t* wuqT = (bf16_t*)(lnd_p(p->ws) + OFF_WUQ);
    constexpr int N_AB = NL * 8 * 16, N_C = NL * 4 * 2 * 2;
    for (int it = BID(); it < N_AB + N_C; it += NBLK()) {
        __syncthreads();
        bf16_t* dst; int ld;
        if (it < N_AB) { const int l = it >> 7, g = (it >> 4) & 7, n0 = (it & 15) * 64;
            if (g < 4) {
                for (int i = tid; i < 128 * 64; i += NTHREADS) { const int d = i >> 6, rr = i & 63; tx[d * 68 + rr] = p->w_out[((size_t)l * DM + g * 128 + d) * DM + n0 + rr] * p->pool_scale[l * DPOOL + g * 128 + d]; }
                for (int i = tid; i < 128 * 128; i += NTHREADS) { const int c = i >> 7, d = i & 127; ty[d * 132 + c] = p->w_pool[(((size_t)l * 4 + g) * 128 + c) * 128 + d]; }
            } else { const int h = g - 4;
                for (int i = tid; i < 128 * 64; i += NTHREADS) { const int d = i >> 6, rr = i & 63; tx[d * 68 + rr] = p->w_out[((size_t)l * DM + 512 + h * 128 + d) * DM + n0 + rr]; }
                for (int i = tid; i < 128 * 128; i += NTHREADS) { const int c = i >> 7, d = i & 127; ty[d * 132 + c] = p->w_ukv[((size_t)l * KVLORA + c) * 1024 + h * 256 + 128 + d] * p->kv_norm[l * KVLORA + c]; }
            }
            dst = woutT + ((size_t)l * DM + n0) * DM + g * 128; ld = DM;
        } else { const int q = it - N_AB, l = q >> 4, h = (q >> 2) & 3, jt = (q >> 1) & 1, kc = q & 1;
            for (int i = tid; i < 128 * 64; i += NTHREADS) { const int d = i & 127, rr = i >> 7, j = jt * 64 + rr; tx[d * 68 + rr] = p->w_ukv[((size_t)l * KVLORA + j) * 1024 + h * 256 + d] * p->kv_norm[l * KVLORA + j]; }
            for (int i = tid; i < 128 * 128; i += NTHREADS) { const int d = i & 127, c = i >> 7, k = kc * 128 + c; ty[d * 132 + c] = p->w_uq[((size_t)l * QLORA + k) * 768 + h * 192 + d] * p->q_norm[l * QLORA + k]; }
            dst = wuqT + ((size_t)l * 768 + h * 192 + jt * 64) * 256 + kc * 128; ld = 256;
        }
        __syncthreads();
        const int r0 = (tid >> 5) * 4, c0 = (tid & 31) * 4; f32x4 acc[4];
#pragma unroll
        for (int j = 0; j < 4; ++j) acc[j] = (f32x4){0.f, 0.f, 0.f, 0.f};
#pragma unroll 4
        for (int d = 0; d < 128; ++d) { const f32x4 xv = *(const f32x4*)(tx + d * 68 + r0), yv = *(const f32x4*)(ty + d * 132 + c0);
            acc[0] += xv[0] * yv; acc[1] += xv[1] * yv; acc[2] += xv[2] * yv; acc[3] += xv[3] * yv; }
#pragma unroll
        for (int j = 0; j < 4; ++j) st_bf16x4(dst + (size_t)(r0 + j) * ld + c0, acc[j]);
    }
    __syncthreads();
}

__device__ __forceinline__ void phase_mix_thin(const int wv_, KP p) {
    unsigned char* ws = lnd_p(p->ws);
    const bf16_t* proj = (const bf16_t*)(ws + OFF_PROJ); bf16_t* dP = (bf16_t*)(ws + OFF_CAT); float* rsq = (float*)(ws + OFF_RSQ); float* rskv = (float*)(ws + OFF_RSKV);
    bf16_t* Kf = (bf16_t*)(ws + OFF_KF); const f32x2* cs = (const f32x2*)(ws + OFF_CS);
    const int tid = TID(), wid = tid >> 6, lane = tid & 63;
    const int g = lane >> 4, w = 2 << g, left = w >> 1, right = w - 1 - left;
    for (int t0 = (BID() * 8 + wid) * 4; t0 < T; t0 += NBLK() * 32) {
        const int b = t0 >> 12, s0 = t0 & 4095;
        u32x4 nb[19];
#pragma unroll
        for (int r = 0; r < 19; ++r) { const int sr = min(max(s0 + r - 8, 0), SEQ - 1); nb[r] = *(const u32x4*)(proj + ((size_t)b * SEQ + sr) * 1024 + lane * 8); }
        u32x2 wq[4]; unsigned wkv[4]; float kr[4]; f32x2 cc[4];
#pragma unroll
        for (int i = 0; i < 4; ++i) { const bf16_t* row = proj + (size_t)(t0 + i) * 1024; wq[i] = *(const u32x2*)(row + 512 + lane * 4); wkv[i] = *(const unsigned*)(row + 768 + lane * 2); kr[i] = bf2f(row[896 + lane]);
            cc[i] = cs[(size_t)(t0 + i) * 32 + (lane & 31)]; }
#pragma unroll
        for (int i = 0; i < 4; ++i) { const int t = t0 + i, s = s0 + i;
            { const float a0 = bflo(wq[i].x), a1 = bfhi(wq[i].x), a2 = bflo(wq[i].y), a3 = bfhi(wq[i].y);
              const float ss = wave_sum((a0 * a0 + a1 * a1) + (a2 * a2 + a3 * a3)); if (lane == 0) rsq[t] = rsqrtf(ss * (1.f / QLORA) + EPS); }
            { const float a0 = bflo(wkv[i]), a1 = bfhi(wkv[i]);
              const float ss = wave_sum(a0 * a0 + a1 * a1); const float rk = rsqrtf(ss * (1.f / KVLORA) + EPS);
              *(unsigned*)(Kf + ((size_t)b * SEQ + s) * DQK + lane * 2) = cvt_pk_bf16(a0 * rk, a1 * rk); }
            { const float mine = kr[i], other = shx<32>(mine); const int pp = lane & 31; const f32x2 c = cc[i];
              const float t1 = lane < 32 ? mine : other, t2 = lane < 32 ? other : mine; const float o = lane < 32 ? t1 * c.x - t2 * c.y : t1 * c.y + t2 * c.x;
              const bf16_t ob = (bf16_t)(cvt_pk_bf16(o, 0.f) & 0xffffu); const int jj = 128 + 2 * pp + (lane >> 5);
              Kf[((size_t)b * SEQ + s) * DQK + jj] = ob; }
            { const int lo = max(s - left, 0), hi = min(s + right + 1, SEQ); float sum[8];
#pragma unroll
              for (int q = 0; q < 8; ++q) sum[q] = 0.f;
#pragma unroll
              for (int j = 0; j < 16; ++j) { const int sj = s + j - 8; const float m = (sj >= lo && sj < hi) ? 1.f : 0.f; const u32x4 v = nb[i + j];
                  sum[0] += m * bflo(v.x); sum[1] += m * bfhi(v.x); sum[2] += m * bflo(v.y); sum[3] += m * bfhi(v.y); sum[4] += m * bflo(v.z); sum[5] += m * bfhi(v.z); sum[6] += m * bflo(v.w); sum[7] += m * bfhi(v.w); }
              const u32x4 c4 = nb[i + 8]; const float inv = 1.f / (float)(hi - lo);
              u32x4 o; o.x = cvt_pk_bf16(sum[0] * inv - bflo(c4.x), sum[1] * inv - bfhi(c4.x)); o.y = cvt_pk_bf16(sum[2] * inv - bflo(c4.y), sum[3] * inv - bfhi(c4.y));
              o.z = cvt_pk_bf16(sum[4] * inv - bflo(c4.z), sum[5] * inv - bfhi(c4.z)); o.w = cvt_pk_bf16(sum[6] * inv - bflo(c4.w), sum[7] * inv - bfhi(c4.w));
              *(u32x4*)(dP + (size_t)t * 1024 + lane * 8) = o; }
            __builtin_amdgcn_sched_barrier(0);
        }
    }
}

#ifndef PROBE_VAR
#define PROBE_VAR 0
#endif
__device__ __forceinline__ void phase_attn(const int wv_, KP p, unsigned char* lds, int dry) {
    unsigned char* ws = lnd_p(p->ws);
    const bf16_t* Qf = (const bf16_t*)(ws + OFF_QF); const bf16_t* Kf = (const bf16_t*)(ws + OFF_KF); bf16_t* cat = (bf16_t*)(ws + OFF_CAT);
    const int G = NBLK();
    for (int i = BID(); i < NB * NH * 16; i += G) {
        int u = i;
        if (G == 256) { const int rnd = i >> 8, bid = i & 255, xcd = bid & 7, j = bid >> 3; u = (((rnd * 8 + xcd) * 2 + (j >> 4)) << 4) + (j & 15); }
        const int bh = u >> 4, qb = u & 15, b = bh >> 2, h = bh & 3;
        if (!dry) att::attn_dense_body<0>(wv_, Qf + ((size_t)bh * SEQ + qb * 256) * DQK, Kf + (size_t)b * SEQ * DQK, Kf + (size_t)b * SEQ * DQK,
                             cat + ((size_t)b * SEQ + qb * 256) * 1024 + 512 + h * 128, SEQ, lds);
        else att::attn_dense_body<PROBE_VAR>(wv_, Qf + ((size_t)bh * SEQ + qb * 256) * DQK, Kf + (size_t)b * SEQ * DQK, Kf + (size_t)b * SEQ * DQK,
                             (bf16_t*)(lnd_p(p->ws) + OFF_QX) + ((size_t)b * SEQ + qb * 256) * 1024 + 512 + h * 128, SEQ, lds);
    }
}

__device__ __forceinline__ float bf_el(const u32x4& v, int e) { const unsigned w = (e >> 1) == 0 ? v.x : (e >> 1) == 1 ? v.y : (e >> 1) == 2 ? v.z : v.w; return (e & 1) ? bfhi(w) : bflo(w); }
__device__ __forceinline__ void phase_router(const int wv_, KP p, int l, unsigned char* lds) {
    float* W = (float*)lds;
    const int tid = TID(), wid = tid >> 6, lane = tid & 63, r = lane & 15, kq = lane >> 4;
    const float* wr = p->w_router + (size_t)l * DM * NE; const float* g = p->norm_ffn + l * DM;
    __syncthreads();
    for (int idx = tid; idx < DM * NE; idx += NTHREADS) { const int k = idx >> 4, e = idx & 15; W[k * 18 + e] = wr[idx] * g[k]; }
    __syncthreads();
    const bf16_t* x = (const bf16_t*)(lnd_p(p->ws) + OFF_XB); float* aff = (float*)(lnd_p(p->ws) + OFF_AFF); float* rsC = (float*)(lnd_p(p->ws) + OFF_RSC);
    const float* wl = W + (8 * kq) * 18 + r;
    for (int t0 = (BID() * 8 + wid) * 16; t0 < T; t0 += NBLK() * 128) {
        const bf16_t* xr = x + (size_t)(t0 + r) * DM + 8 * kq;
        f32x4 acc0 = {0.f, 0.f, 0.f, 0.f}, acc1 = {0.f, 0.f, 0.f, 0.f}; float ss = 0.f;
        u32x4 xc[8];
#pragma unroll
        for (int i = 0; i < 8; ++i) xc[i] = *(const u32x4*)(xr + 32 * i);
#pragma unroll
        for (int jc = 0; jc < 4; ++jc) {
            u32x4 xn[8];
            if (jc < 3) {
#pragma unroll
                for (int i = 0; i < 8; ++i) xn[i] = *(const u32x4*)(xr + 32 * (8 * (jc + 1) + i)); }
#pragma unroll
            for (int i = 0; i < 8; ++i) { const float* wj = wl + (32 * (8 * jc + i)) * 18;
#pragma unroll
                for (int e = 0; e < 8; e += 2) { const float a0 = bf_el(xc[i], e), a1 = bf_el(xc[i], e + 1); ss += a0 * a0 + a1 * a1;
                    acc0 = __builtin_amdgcn_mfma_f32_16x16x4f32(a0, wj[e * 18], acc0, 0, 0, 0);
                    acc1 = __builtin_amdgcn_mfma_f32_16x16x4f32(a1, wj[(e + 1) * 18], acc1, 0, 0, 0); } }
            if (jc < 3) {
#pragma unroll
                for (int i = 0; i < 8; ++i) xc[i] = xn[i]; }
        }
        ss += shx<16>(ss); ss = shx_sum32(ss);
        const float rs = rsqrtf(ss * (1.f / DM) + EPS);
        if (kq == 0) rsC[t0 + r] = rs;
        const int b = t0 >> 12, sq = t0 & 4095; f32x4 pr;
#pragma unroll
        for (int q = 0; q < 4; ++q) { const float rq = __uint_as_float((unsigned)__builtin_amdgcn_ds_bpermute((4 * kq + q) << 2, (int)__float_as_uint(rs)));
            const float v = (acc0[q] + acc1[q]) * rq;
            float m = fmaxf(v, shx<8>(v)); m = fmaxf(m, shx<4>(m)); m = fmaxf(m, shx<2>(m)); m = fmaxf(m, shx<1>(m));
            const float e = __expf(v - m); float z = e + shx<8>(e); z += shx<4>(z); z += shx<2>(z); z += shx<1>(z);
            pr[q] = e / z; }
        *(f32x4*)(aff + ((size_t)(b * NE + r)) * SEQ + sq + 4 * kq) = pr;
    }
    __syncthreads();
}

__device__ __forceinline__ void phase_select(const int wv_, KP p, unsigned char* lds) {
    unsigned* hist = (unsigned*)lds; unsigned* wtot = hist + 256; unsigned* bc = wtot + 16; int* sel = (int*)(bc + 16);
    unsigned char* ws = lnd_p(p->ws);
    const float* aff = (const float*)(ws + OFF_AFF); int* slot = (int*)(ws + OFF_SLOT); float* gate = (float*)(ws + OFF_GATE); float* rsrow = (float*)(ws + OFF_RSROW);
    const float* rsC = (const float*)(ws + OFF_RSC); const bf16_t* xb = (const bf16_t*)(ws + OFF_XB); bf16_t* xt = (bf16_t*)(ws + OFF_XT);
    const int tid = TID(), wid = tid >> 6, lane = tid & 63;
    int* tok = (int*)(ws + OFF_XT);
    for (int item = BID(); item < NB * NE; item += NBLK()) {
        const int par = 0; const int b = item >> 4, e = item & 15;
        const float* a = aff + (size_t)item * SEQ + tid * 8;
        const f32x4 v0 = *(const f32x4*)a, v1 = *(const f32x4*)(a + 4);
        float v[8] = {v0[0], v0[1], v0[2], v0[3], v1[0], v1[1], v1[2], v1[3]}; unsigned bits[8];
#pragma unroll
        for (int i = 0; i < 8; ++i) bits[i] = __float_as_uint(v[i]);
        unsigned prefix = 0;
        for (int bit = 30; bit >= 0; --bit) {
            const unsigned cand = prefix | (1u << bit); unsigned wc_ = 0;
#pragma unroll
            for (int i = 0; i < 8; ++i) wc_ += (unsigned)__popcll(__ballot(bits[i] >= cand));
            unsigned* slotw = wtot + ((bit & 1) << 3);
            if (lane == 0) slotw[wid] = wc_;
            __syncthreads();
            unsigned tot = 0;
#pragma unroll
            for (int w = 0; w < 8; ++w) tot += slotw[w];
            if (tot >= (unsigned)CAP) prefix = cand;
        }
        unsigned cgt = 0;
#pragma unroll
        for (int i = 0; i < 8; ++i) cgt += (unsigned)__popcll(__ballot(bits[i] > prefix));
        __syncthreads();
        if (lane == 0) bc[wid] = cgt;
        __syncthreads();
        unsigned remaining = CAP;
#pragma unroll
        for (int w = 0; w < 8; ++w) remaining -= bc[w];
        const unsigned thr = prefix, need = remaining;
        unsigned cg = 0, ce = 0;
#pragma unroll
        for (int i = 0; i < 8; ++i) { cg += bits[i] > thr ? 1u : 0u; ce += bits[i] == thr ? 1u : 0u; }
        unsigned pk = cg | (ce << 16), incl = pk;
#pragma unroll
        for (int o = 1; o < 64; o <<= 1) { const unsigned y = (unsigned)__builtin_amdgcn_ds_bpermute((lane - o) << 2, (int)incl); if (lane >= o) incl += y; }
        __syncthreads();
        if (lane == 63) wtot[wid] = incl;
        __syncthreads();
        unsigned base = 0;
#pragma unroll
        for (int w = 0; w < 8; ++w) base += (w < wid) ? wtot[w] : 0u;
        const unsigned ex = base + incl - pk; unsigned gb = ex & 0xffffu, eb = ex >> 16;
#pragma unroll
        for (int i = 0; i < 8; ++i) { const int s = tid * 8 + i; int pos = -1;
            if (bits[i] > thr) { pos = (int)(gb + (eb < need ? eb : need)); ++gb; }
            else if (bits[i] == thr) { if (eb < need) pos = (int)(gb + eb); ++eb; }
            if (par == 0) slot[((size_t)b * SEQ + s) * NE + e] = pos;
            if (pos >= 0) { tok[(size_t)item * CAP + pos] = s; gate[(size_t)item * CAP + pos] = v[i]; rsrow[(size_t)item * CAP + pos] = rsC[b * SEQ + s]; } }
        __syncthreads();
    }
}

__device__ __forceinline__ void acc8(f32x4 (&v)[2], const u32x4& w, float wt) {
    v[0][0] += wt * bflo(w.x); v[0][1] += wt * bfhi(w.x); v[0][2] += wt * bflo(w.y); v[0][3] += wt * bfhi(w.y); v[1][0] += wt * bflo(w.z); v[1][1] += wt * bfhi(w.z); v[1][2] += wt * bflo(w.w); v[1][3] += wt * bfhi(w.w); }
__device__ __forceinline__ void phase_combine(const int wv_, KP p, int last, int dry) {
    unsigned char* ws = lnd_p(p->ws);
    const int* slot = (const int*)(ws + OFF_SLOT); const bf16_t* Y = (const bf16_t*)(ws + OFF_Y); const bf16_t* xin = (const bf16_t*)(ws + OFF_XB); bf16_t* xb = (bf16_t*)(ws + (dry ? OFF_P : OFF_XB)); float* rsA = (float*)(ws + (dry ? OFF_RSQ : OFF_RSA));
    float* xo = dry ? (float*)(ws + OFF_SX) : p->out;
    const int tid = TID(), wid = tid >> 6, lane = tid & 63;
    const int step = NBLK() * 8; int t = BID() * 8 + wid;
    int myslot = (t < T && lane < NE) ? slot[(size_t)t * NE + lane] : -1;
    for (; t < T; t += step) {
        const int b = t >> 12; const int tn = t + step;
        const int nslot = (tn < T && lane < NE) ? slot[(size_t)tn * NE + lane] : -1;
        unsigned long long mask = __ballot(myslot >= 0);
        u32x4 xw[2];
#pragma unroll
        for (int i = 0; i < 2; ++i) xw[i] = *(const u32x4*)(xin + (size_t)t * DM + i * 512 + lane * 8);
        u32x4 yw[4][2]; float wt[4];
#pragma unroll
        for (int j = 0; j < 4; ++j) { int e = 0, c = 0; wt[j] = 0.f;
            if (mask) { e = __builtin_ctzll(mask); mask &= mask - 1; c = __builtin_amdgcn_readlane(myslot, e); wt[j] = 1.f; }
            const bf16_t* yr = Y + ((size_t)(b * NE + e) * CAP + c) * DM;
#pragma unroll
            for (int i = 0; i < 2; ++i) yw[j][i] = *(const u32x4*)(yr + i * 512 + lane * 8); }
        f32x4 v[2][2];
#pragma unroll
        for (int i = 0; i < 2; ++i) { v[i][0] = (f32x4){0.f, 0.f, 0.f, 0.f}; v[i][1] = (f32x4){0.f, 0.f, 0.f, 0.f}; acc8(v[i], xw[i], 1.f); }
#pragma unroll
        for (int j = 0; j < 4; ++j)
#pragma unroll
            for (int i = 0; i < 2; ++i) acc8(v[i], yw[j][i], wt[j]);
        while (mask) { const int e = __builtin_ctzll(mask); mask &= mask - 1; const int c = __builtin_amdgcn_readlane(myslot, e); const bf16_t* yr = Y + ((size_t)(b * NE + e) * CAP + c) * DM;
#pragma unroll
            for (int i = 0; i < 2; ++i) { const u32x4 w2 = *(const u32x4*)(yr + i * 512 + lane * 8); acc8(v[i], w2, 1.f); } }
        float ss = 0.f;
#pragma unroll
        for (int i = 0; i < 2; ++i)
#pragma unroll
            for (int h = 0; h < 2; ++h) ss += (v[i][h][0] * v[i][h][0] + v[i][h][1] * v[i][h][1]) + (v[i][h][2] * v[i][h][2] + v[i][h][3] * v[i][h][3]);
        ss = wave_sum(ss); const float rs = rsqrtf(ss * (1.f / DM) + EPS);
        if (last) {
#pragma unroll
            for (int i = 0; i < 2; ++i)
#pragma unroll
                for (int h = 0; h < 2; ++h) { const int col = i * 512 + lane * 8 + h * 4; const f32x4 g = *(const f32x4*)(p->norm_final + col); *(f32x4*)(xo + (size_t)t * DM + col) = v[i][h] * rs * g; }
        } else {
#pragma unroll
            for (int i = 0; i < 2; ++i) st_bf16x8(xb + (size_t)t * DM + i * 512 + lane * 8, v[i][0], v[i][1]);
            if (lane == 0) rsA[t] = rs;
        }
        myslot = nslot;
    }
}

struct EpiDown {
    bf16_t* Y; const float* gate; static constexpr bool STAGED = true;
    __device__ __forceinline__ float rowscale(const GU& u, int r) const { return gate[u.pm * 256 + r]; }
    __device__ __forceinline__ void operator()(ACC_T, const GU& u, int wr, int wc, int fr, int fq, const LAS float* sc) const {
#pragma unroll
        for (int ai = 0; ai < 2; ++ai)
#pragma unroll
            for (int m = 0; m < 4; ++m) { const int row = ROW_OF; const float s = sc[RLOC_OF];
#pragma unroll
                for (int bj = 0; bj < 2; ++bj) st_bf16x8(Y + (size_t)row * DM + COL8_OF, acc[ai][bj][m][0] * s, acc[ai][bj][m][1] * s); }
    }
};

constexpr int PH_PER_LAYER = 15, PH_TOTAL = 3 + NL * PH_PER_LAYER;

__global__ void __launch_bounds__(NTHREADS, 2) mk_fwd(Params pk) {
    extern __shared__ __attribute__((aligned(16))) unsigned char lds[];
    const int wv_ = __builtin_amdgcn_readfirstlane((int)threadIdx.x >> 6);
    KP p = kargs(); unsigned char* ws = lnd_p(p->ws);
    const int tid = TID();
    volatile LAS unsigned* bst = (volatile LAS unsigned*)(LAS unsigned char*)(lds + LDS_BYTES - 16);
    if (tid == 0) { bst[0] = 0u; bst[1] = 0u; }
    __syncthreads();
    const int lo = pk.ph_lo, hi = pk.ph_hi;
    const bool fused = (hi - lo) > 1;
    XcdBarrier bar; bar.bar = (unsigned*)(ws + OFF_BAR); bar.x = 0; bar.st = bst;
    if (fused) bar = xcd_barrier_post((unsigned*)(ws + OFF_BAR), bst, tid == 0);
#ifdef ONLY_J
#define ON(j) ((j) == ONLY_J)
#else
#define ON(j) true
#endif
#ifndef PROBE_J
#define PROBE_J (-1)
#endif
#ifndef PROBE_N
#define PROBE_N 1
#endif
#define REPS(j) ((j) == PROBE_J ? PROBE_N + 1 : 1)
#define IN(k) (lo <= (k) && (k) < hi)
#define SEAM(k) do { if (IN(k) && IN((k) + 1)) xcd_barrier(bar, TID() == 0); } while (0)

    if (ON(100) && IN(0)) for (int rep = 0; rep < REPS(100); ++rep) { phase_prologue(wv_, kargs(), lds); phase_weff(wv_, kargs(), lds); SEAM(0); }
    if (ON(101) && IN(1)) for (int rep = 0; rep < REPS(101); ++rep) { KP p = kargs(); unsigned char* ws = lnd_p(p->ws);
        static_assert(OFF_VXT == OFF_KX + (size_t)NL * 2048 * 1024 * 2, "vx must follow kx");
        { DescKV d{(const bf16_t*)(ws + OFF_MB), (const bf16_t*)(ws + OFF_WXK), (const bf16_t*)(ws + OFF_WXV), 1024, 1024, 1024, 256}; EpiBf16 E{(bf16_t*)(ws + OFF_KX), 1024, nullptr, 1.f}; GEMM(lds, d, E); }
        SEAM(1);
    }
    for (int l = 0; l < NL; ++l) {
        const int P0 = 3 + l * PH_PER_LAYER;
        if (ON(0) && IN(P0 + 0)) for (int rep = 0; rep < REPS(0); ++rep) { KP p = kargs(); unsigned char* ws = lnd_p(p->ws); bf16_t* xb = (bf16_t*)(ws + OFF_XB);
            DescPlain d{xb, (const bf16_t*)(ws + OFF_WIN) + (size_t)l * 1024 * 1024, 1024, 1024, 1024, T / 256, 4, (T / 256) * 4};
            EpiBf16 E{(bf16_t*)(ws + OFF_PROJ), 1024, (const float*)(ws + OFF_RSA), 1.f}; GEMM(lds, d, E); SEAM(P0 + 0);
        }
        if (ON(1) && IN(P0 + 1)) for (int rep = 0; rep < REPS(1); ++rep) { phase_mix_thin(wv_, kargs()); SEAM(P0 + 1); }
        if (ON(2) && IN(P0 + 2)) for (int rep = 0; rep < REPS(2); ++rep) { KP p = kargs(); unsigned char* ws = lnd_p(p->ws); bf16_t* xb = (bf16_t*)(ws + OFF_XB);
            { DescPlain d{(const bf16_t*)(ws + OFF_PROJ) + 512, (const bf16_t*)(ws + OFF_WUQ) + (size_t)l * 768 * 256, 1024, 256, 256, T / 256, 3, (T / 256) * 3};
              EpiQ E{(bf16_t*)(ws + OFF_QF), (const float*)(ws + OFF_RSQ), (const f32x2*)(ws + OFF_CS)}; GEMM(lds, d, E); }
            { DescMt d{(const bf16_t*)(ws + OFF_KX), (const bf16_t*)(ws + OFF_WXQ), 1024, 1024, 256, 128, l * 128, 128}; EpiBf16 E{(bf16_t*)(ws + OFF_MT), 1024, nullptr, 1.f}; GEMM(lds, d, E); }
            if (l == 0) { DescNt d{(const bf16_t*)(ws + OFF_WXO), (const bf16_t*)(ws + OFF_VXT), 1024, 1024, 256, 128, 0, 0}; EpiBf16 E{(bf16_t*)(ws + OFF_NT), 1024, nullptr, 1.f}; GEMM(lds, d, E); }
            SEAM(P0 + 2);
        }
        if (ON(3) && IN(P0 + 3)) for (int rep = 0; rep < REPS(3); ++rep) { phase_attn(wv_, kargs(), lds, rep); SEAM(P0 + 3); }
        if (ON(4) && IN(P0 + 4)) for (int rep = 0; rep < REPS(4); ++rep) { KP p = kargs(); unsigned char* ws = lnd_p(p->ws); bf16_t* xb = (bf16_t*)(ws + OFF_XB);
            DescPlain d{(const bf16_t*)(ws + OFF_CAT), (const bf16_t*)(ws + OFF_WOUT) + (size_t)l * DM * DM, 1024, 1024, 1024, T / 256, 4, (T / 256) * 4};
            EpiResid E{xb, rep ? (bf16_t*)(ws + OFF_P) : xb, rep ? nullptr : (float*)(ws + OFF_SSPB)}; GEMM(lds, d, E); SEAM(P0 + 4);
        }
        if (ON(5) && IN(P0 + 5)) for (int rep = 0; rep < REPS(5); ++rep) { KP p = kargs(); unsigned char* ws = lnd_p(p->ws); bf16_t* xb = (bf16_t*)(ws + OFF_XB);
            DescXB d{xb, (const bf16_t*)(ws + OFF_MT) + (size_t)l * NB * 4 * 256 * 1024, 1024, 1024, 1024, (T / 256) * 4};
            EpiSoftmax E{(bf16_t*)(ws + OFF_P), (LAS float*)((LAS unsigned char*)lds + 147456), (const float*)(ws + OFF_SSPB), 0.0625f}; GEMM(lds, d, E); SEAM(P0 + 5);
        }
        if (ON(9) && IN(P0 + 9)) for (int rep = 0; rep < REPS(9); ++rep) { KP p = kargs(); unsigned char* ws = lnd_p(p->ws); bf16_t* xb = (bf16_t*)(ws + OFF_XB);
            DescXB d{(const bf16_t*)(ws + OFF_P), (const bf16_t*)(ws + OFF_NT) + (size_t)l * NB * 1024 * 1024, 1024, 1024, 1024, (T / 256) * 4};
            EpiResid E{xb, rep ? (bf16_t*)(ws + OFF_QX) : xb, nullptr}; GEMM(lds, d, E); SEAM(P0 + 9);
        }
        if (ON(10) && IN(P0 + 10)) for (int rep = 0; rep < REPS(10); ++rep) { phase_router(wv_, kargs(), l, lds); SEAM(P0 + 10); }
        if (ON(11) && IN(P0 + 11)) for (int rep = 0; rep < REPS(11); ++rep) { phase_select(wv_, kargs(), lds);
            if (l + 1 < NL) { KP p = kargs(); unsigned char* ws = lnd_p(p->ws);
                DescNt d{(const bf16_t*)(ws + OFF_WXO), (const bf16_t*)(ws + OFF_VXT), 1024, 1024, 256, 128, (l + 1) * 128, 128}; EpiBf16 E{(bf16_t*)(ws + OFF_NT), 1024, nullptr, 1.f}; GEMM(lds, d, E); }
            SEAM(P0 + 11); }
        if (ON(12) && IN(P0 + 12)) for (int rep = 0; rep < REPS(12); ++rep) { KP p = kargs(); unsigned char* ws = lnd_p(p->ws); bf16_t* xb = (bf16_t*)(ws + OFF_XB);
            const int r0 = (l + 1 < NL) ? 2 * (BID() & 7) : 16;
            EpiSwiglu E{(bf16_t*)(ws + OFF_ACT), (const float*)(ws + OFF_RSROW)};
            if (r0 > 0) { DescGU d{xb, (const int*)(ws + OFF_XT), (const bf16_t*)(ws + OFF_WGU) + (size_t)l * NE * 4096 * 1024, 1024, 1024, 1024, r0 * 256, 0}; GEMM(lds, d, E); }
            if (l + 1 < NL) conv_fast(wv_, p, ws, lds, (l + 1) * NE * 384, (l + 2) * NE * 384);
            if (r0 < 16) { DescGU d{xb, (const int*)(ws + OFF_XT), (const bf16_t*)(ws + OFF_WGU) + (size_t)l * NE * 4096 * 1024, 1024, 1024, 1024, (16 - r0) * 256, r0 * 256}; GEMM(lds, d, E); }
            SEAM(P0 + 12);
        }
        if (ON(13) && IN(P0 + 13)) for (int rep = 0; rep < REPS(13); ++rep) { KP p = kargs(); unsigned char* ws = lnd_p(p->ws); bf16_t* xb = (bf16_t*)(ws + OFF_XB);
            DescDown d{(const bf16_t*)(ws + OFF_ACT), (const bf16_t*)(ws + OFF_WD) + (size_t)l * NE * 1024 * 2048, 2048, 2048, 2048, NE * 64};
            EpiDown E{(bf16_t*)(ws + OFF_Y), (const float*)(ws + OFF_GATE)}; GEMM(lds, d, E); SEAM(P0 + 13);
        }
        if (ON(14) && IN(P0 + 14)) for (int rep = 0; rep < REPS(14); ++rep) { phase_combine(wv_, kargs(), l == NL - 1, rep); SEAM(P0 + 14); }
    }
#undef IN
#undef SEAM
}

#ifndef MK_FUSED
#define MK_FUSED 1
#endif
extern "C" void kernel_launch(void* const* d_in, const int* in_sizes, int n_in, void* d_out, int out_size, void* d_ws, size_t ws_size, hipStream_t stream) {
    static int grid = 0;
    if (grid == 0) {
        if (n_in != 23 || in_sizes[0] != T * DM || out_size != T * DM || ws_size < WS_NEED) {
            fprintf(stderr, "kernel_launch: unexpected shapes: n_in %d in0 %d out %d ws %zu (need %zu)\n", n_in, n_in > 0 ? in_sizes[0] : -1, out_size, ws_size, (size_t)WS_NEED); grid = -1; return; }
        int dev = 0, cus = 0, per_cu = 0;
        if (hipGetDevice(&dev) != hipSuccess || hipDeviceGetAttribute(&cus, hipDeviceAttributeMultiprocessorCount, dev) != hipSuccess) { grid = -1; return; }
        if (hipFuncSetAttribute((const void*)mk_fwd, hipFuncAttributeMaxDynamicSharedMemorySize, LDS_BYTES) != hipSuccess) { fprintf(stderr, "kernel_launch: hipFuncSetAttribute failed\n"); grid = -1; return; }
        if (hipOccupancyMaxActiveBlocksPerMultiprocessor(&per_cu, (const void*)mk_fwd, NTHREADS, LDS_BYTES) != hipSuccess || per_cu < 1) fprintf(stderr, "kernel_launch: occupancy query says %d\n", per_cu);
        (void)hipGetLastError();
        grid = cus;
    }
    if (grid < 0) return;
    (void)hipMemsetAsync((char*)d_ws + OFF_BAR, 0, XCD_BAR_WORDS * sizeof(unsigned), stream);
    Params p{};
    p.x = (const float*)d_in[0]; p.mem = (const float*)d_in[1]; p.pos = (const int*)d_in[2]; p.norm_mix = (const float*)d_in[3]; p.w_in = (const float*)d_in[4];
    p.q_norm = (const float*)d_in[5]; p.kv_norm = (const float*)d_in[6]; p.w_uq = (const float*)d_in[7]; p.w_ukv = (const float*)d_in[8]; p.w_pool = (const float*)d_in[9];
    p.pool_scale = (const float*)d_in[10]; p.w_out = (const float*)d_in[11]; p.norm_x = (const float*)d_in[12]; p.mem_norm = (const float*)d_in[13]; p.wx_q = (const float*)d_in[14];
    p.wx_kv = (const float*)d_in[15]; p.wx_o = (const float*)d_in[16]; p.norm_ffn = (const float*)d_in[17]; p.w_router = (const float*)d_in[18]; p.w_gate = (const float*)d_in[19];
    p.w_up = (const float*)d_in[20]; p.w_down = (const float*)d_in[21]; p.norm_final = (const float*)d_in[22];
    p.out = (float*)d_out; p.ws = (unsigned char*)d_ws;
    for (int i = 0; i < 32; ++i) p.inv_freq[i] = (float)pow(10000.0, -(double)i / 32.0);
#if MK_FUSED
    p.ph_lo = 0; p.ph_hi = PH_TOTAL;
    hipLaunchKernelGGL(mk_fwd, dim3(grid), dim3(NTHREADS), LDS_BYTES, stream, p);
#else
    for (int ph = 0; ph < PH_TOTAL; ++ph) { p.ph_lo = ph; p.ph_hi = ph + 1; hipLaunchKernelGGL(mk_fwd, dim3(grid), dim3(NTHREADS), LDS_BYTES, stream, p); }
#endif
    const hipError_t le = hipPeekAtLastError();
    if (le != hipSuccess) fprintf(stderr, "kernel_launch: launch failed: %s\n", hipGetErrorName(le));
}
```
